# Optimizing an MI355X kernel written in HIP

```python
import jax
import jax.numpy as jnp
from jax import lax
import numpy as np

D_MODEL = 1024
BATCH = 4
SEQ = 4096
DEPTH = 4

CTX_LEN = 256
GRID_W = 64
N_EVEN = (DEPTH + 1) // 2
N_ODD = DEPTH // 2
EPS = 1e-6

RET_HEADS = 4
RET_HEAD_DIM = D_MODEL // 8
RET_W = RET_HEADS * RET_HEAD_DIM
RET_CHUNK = 128
ROPE_BASE = 10000.0
ROPE_PAIRS = (RET_HEAD_DIM // 8, 3 * RET_HEAD_DIM // 16, 3 * RET_HEAD_DIM // 16)
CONV_CH = D_MODEL // 2
CONV_K = 31
EVEN_IN = 4 * RET_W + 2 * CONV_CH
EVEN_MIX = RET_W + CONV_CH
POOL_CH = D_MODEL // 2
POOL_WINDOWS = (2, 4, 8, 16)
POOL_GROUPS = len(POOL_WINDOWS)
POOL_GC = POOL_CH // POOL_GROUPS
SG_CH = D_MODEL // 2
SG_GROUPS = 4
SG_GC = SG_CH // SG_GROUPS
SG_CHUNK = 128
ODD_IN = POOL_CH + 2 * SG_CH
ODD_MIX = POOL_CH + SG_CH
D_FF = ((8 * D_MODEL // 3 + 255) // 256) * 256

kernel_name = 'hybrid_retention_conformer_pool_gmlp_prefix_dit'


def rms_norm(x, w):
    x32 = x.astype(jnp.float32)
    y = x32 * lax.rsqrt(jnp.mean(x32 * x32, axis=-1, keepdims=True) + EPS)
    return (y * w.astype(jnp.float32)).astype(x.dtype)


def layer_norm(x, w, b):
    x32 = x.astype(jnp.float32)
    mu = jnp.mean(x32, axis=-1, keepdims=True)
    xc = x32 - mu
    y = xc * lax.rsqrt(jnp.mean(xc * xc, axis=-1, keepdims=True) + EPS)
    return (y * w.astype(jnp.float32) + b.astype(jnp.float32)).astype(x.dtype)


def modulate(h, shift, scale):
    return h * (1.0 + scale) + shift


def swiglu(h, w_gate, w_up, w_down):
    return (jax.nn.silu(h @ w_gate) * (h @ w_up)) @ w_down


def rope_angles(p_seq, p_row, p_col):
    parts = []
    for p, n in zip((p_seq, p_row, p_col), ROPE_PAIRS):
        freq = ROPE_BASE ** (-jnp.arange(n, dtype=jnp.float32) / n)
        parts.append(p[:, None] * freq[None, :])
    return jnp.concatenate(parts, axis=-1)


def apply_rope(t, ang):
    t32 = t.astype(jnp.float32)
    half = t32.shape[-1] // 2
    t1, t2 = t32[..., :half], t32[..., half:]
    cos, sin = jnp.cos(ang), jnp.sin(ang)
    return jnp.concatenate([t1 * cos - t2 * sin, t1 * sin + t2 * cos], axis=-1)


def split_heads(t):
    b, l, _ = t.shape
    return t.reshape(b, l, RET_HEADS, RET_HEAD_DIM).transpose(0, 2, 1, 3)


def retention_chunkwise(q, k, v, log_g, s0, inclusive):
    b, h, l, dk = q.shape
    dv = v.shape[-1]
    n = l // RET_CHUNK
    qc = q.reshape(b, h, n, RET_CHUNK, dk)
    kc = k.reshape(b, h, n, RET_CHUNK, dk)
    vc = v.reshape(b, h, n, RET_CHUNK, dv)
    pos = jnp.arange(RET_CHUNK, dtype=jnp.float32)
    diff = pos[:, None] - pos[None, :]
    if inclusive:
        mask = diff >= 0
        expo = diff
        xi_exp = pos + 1.0
    else:
        mask = diff > 0
        expo = diff - 1.0
        xi_exp = pos
    lg = log_g[:, None, None]
    dmat = jnp.where(mask[None], jnp.exp(lg * jnp.where(mask, expo, 0.0)[None]), 0.0)
    xi = jnp.exp(log_g[:, None] * xi_exp[None, :])
    zeta = jnp.exp(log_g[:, None] * (RET_CHUNK - 1.0 - pos)[None, :])
    chunk_decay = jnp.exp(log_g * RET_CHUNK)[None, :, None, None]
    scores = jnp.einsum('bhncd,bhnmd->bhncm', qc, kc) * dmat[None, :, None]
    intra = jnp.einsum('bhncm,bhnme->bhnce', scores, vc)
    kv = jnp.einsum('bhnmd,hm,bhnme->bhnde', kc, zeta, vc)

    def step(s, kv_n):
        return s * chunk_decay + kv_n, s

    _, s_prev = lax.scan(step, s0, jnp.moveaxis(kv, 2, 0))
    inter = jnp.einsum('bhncd,hc,nbhde->bhnce', qc, xi, s_prev)
    return (intra + inter).reshape(b, h, l, dv)


def retention_final_states(k, v, log_g2):
    l = k.shape[2]
    pos = jnp.arange(l, dtype=jnp.float32)
    w_f = jnp.exp(log_g2[0][:, None] * (l - 1.0 - pos)[None, :])
    w_b = jnp.exp(log_g2[1][:, None] * pos[None, :])
    s_f = jnp.einsum('bhld,hl,bhle->bhde', k, w_f, v)
    s_b = jnp.einsum('bhld,hl,bhle->bhde', k, w_b, v)
    return s_f, s_b


def bidir_retention(q, k, v, log_g2, s_f, s_b):
    flip = lambda t: jnp.flip(t, axis=2)
    fwd = retention_chunkwise(q, k, v, log_g2[0], s_f, True)
    bwd = flip(retention_chunkwise(flip(q), flip(k), flip(v), log_g2[1], s_b, False))
    return fwd + bwd


def retention_kv(h, w_in, ang):
    k = apply_rope(split_heads(h @ w_in[:, RET_W:2 * RET_W]), ang)
    v = split_heads(h @ w_in[:, 2 * RET_W:3 * RET_W]).astype(jnp.float32)
    return k, v


def even_project(h, w_in, ang):
    p = h @ w_in
    q, k, v, g, a, gb = jnp.split(p, [RET_W, 2 * RET_W, 3 * RET_W, 4 * RET_W, 4 * RET_W + CONV_CH], axis=-1)
    q = apply_rope(split_heads(q), ang) * (RET_HEAD_DIM ** -0.5)
    k = apply_rope(split_heads(k), ang)
    v = split_heads(v).astype(jnp.float32)
    return q, k, v, g, a * jax.nn.sigmoid(gb)


def depthwise_conv(u, w):
    return lax.conv_general_dilated(
        u, w.astype(u.dtype)[:, None, :], window_strides=(1,),
        padding=[(CONV_K // 2, CONV_K // 2)],
        dimension_numbers=('NWC', 'WIO', 'NWC'), feature_group_count=u.shape[-1])


def even_mix(q, k, v, g, u, s_f, s_b, log_g2, conv_w, ln_w, ln_b, w_out):
    b, _, l, _ = q.shape
    y = bidir_retention(q, k, v, log_g2, s_f, s_b)
    y = y * lax.rsqrt(jnp.mean(y * y, axis=-1, keepdims=True) + EPS)
    y = y.transpose(0, 2, 1, 3).reshape(b, l, RET_W).astype(g.dtype)
    ret_out = jax.nn.silu(g) * y
    conv_out = jax.nn.silu(layer_norm(depthwise_conv(u, conv_w), ln_w, ln_b))
    return jnp.concatenate([ret_out, conv_out], axis=-1) @ w_out


def pool_minus_token(h32):
    b, l, _ = h32.shape
    cs = jnp.concatenate([jnp.zeros((b, 1, POOL_CH), jnp.float32), lax.cumsum(h32, axis=1)], axis=1)
    t = jnp.arange(l)
    outs = []
    for gi, w in enumerate(POOL_WINDOWS):
        left = w // 2
        right = w - 1 - left
        lo = jnp.clip(t - left, 0, l - 1)
        hi = jnp.clip(t + right, 0, l - 1)
        csg = cs[..., gi * POOL_GC:(gi + 1) * POOL_GC]
        mean = (csg[:, hi + 1] - csg[:, lo]) / (hi - lo + 1).astype(jnp.float32)[None, :, None]
        outs.append(mean - h32[..., gi * POOL_GC:(gi + 1) * POOL_GC])
    return jnp.stack(outs, axis=2)


def odd_stream(h, w_in, w_out, pool_w, pool_scale, sg_ln_w, sg_ln_b, sg_w, sg_b):
    b, l, _ = h.shape
    p = h @ w_in
    pc, pd = p[..., :POOL_CH], p[..., POOL_CH:]
    m = pool_minus_token(pc.astype(jnp.float32))
    pool_out = jnp.einsum('blgc,gcd->blgd', m, pool_w.astype(jnp.float32)).reshape(b, l, POOL_CH)
    pool_out = pool_out.astype(h.dtype) * pool_scale
    z = jax.nn.gelu(pd, approximate=False)
    u, v = jnp.split(z, 2, axis=-1)
    v = layer_norm(v, sg_ln_w, sg_ln_b).reshape(b, l // SG_CHUNK, SG_CHUNK, SG_GROUPS, SG_GC)
    s = jnp.einsum('bnpgc,gqp->bnqgc', v, sg_w) + sg_b.T[None, None, :, :, None]
    sg_out = u * s.reshape(b, l, SG_CH)
    return jnp.concatenate([pool_out, sg_out], axis=-1) @ w_out


def setup_inputs(seed: int = 0) -> dict:
    key = jax.random.key(seed)
    ks = jax.random.split(key, 25)
    f32 = jnp.float32
    nrm = lambda k, shape, s: jax.random.normal(k, shape, f32) * s
    gamma0 = 1.0 - 2.0 ** (-5.0 - np.arange(RET_HEADS))
    decay_base = jnp.asarray(np.log(gamma0 / (1.0 - gamma0)), f32)
    return {
        'x': nrm(ks[0], (BATCH, SEQ, D_MODEL), 1.0),
        'c': nrm(ks[1], (BATCH, D_MODEL), 1.0),
        'ctx': nrm(ks[2], (BATCH, CTX_LEN, D_MODEL), 1.0),
        'c_ctx': nrm(ks[3], (D_MODEL,), 1.0),
        'ada_w': nrm(ks[4], (DEPTH, D_MODEL, 6 * D_MODEL), 0.5 * D_MODEL ** -0.5),
        'ada_b': nrm(ks[5], (DEPTH, 6 * D_MODEL), 0.02),
        'norm_w': 1.0 + nrm(ks[6], (DEPTH, 2, D_MODEL), 0.02),
        'even_w_in': nrm(ks[7], (N_EVEN, D_MODEL, EVEN_IN), D_MODEL ** -0.5),
        'even_w_out': nrm(ks[8], (N_EVEN, EVEN_MIX, D_MODEL), EVEN_MIX ** -0.5),
        'ret_decay_logit': decay_base + nrm(ks[9], (N_EVEN, 2, RET_HEADS), 0.1),
        'conv_dw_w': nrm(ks[10], (N_EVEN, CONV_K, CONV_CH), CONV_K ** -0.5),
        'conv_ln_w': 1.0 + nrm(ks[11], (N_EVEN, CONV_CH), 0.02),
        'conv_ln_b': nrm(ks[12], (N_EVEN, CONV_CH), 0.02),
        'odd_w_in': nrm(ks[13], (N_ODD, D_MODEL, ODD_IN), D_MODEL ** -0.5),
        'odd_w_out': nrm(ks[14], (N_ODD, ODD_MIX, D_MODEL), ODD_MIX ** -0.5),
        'pool_w': nrm(ks[15], (N_ODD, POOL_GROUPS, POOL_GC, POOL_GC), POOL_GC ** -0.5),
        'pool_scale': 1.0 + nrm(ks[16], (N_ODD, POOL_CH), 0.02),
        'sg_ln_w': 1.0 + nrm(ks[17], (N_ODD, SG_CH), 0.02),
        'sg_ln_b': nrm(ks[18], (N_ODD, SG_CH), 0.02),
        'sg_w': nrm(ks[19], (N_ODD, SG_GROUPS, SG_CHUNK, SG_CHUNK), 0.5 * SG_CHUNK ** -0.5),
        'sg_b': 1.0 + nrm(ks[20], (N_ODD, SG_GROUPS, SG_CHUNK), 0.02),
        'ffn_w_gate': nrm(ks[21], (DEPTH, D_MODEL, D_FF), D_MODEL ** -0.5),
        'ffn_w_up': nrm(ks[22], (DEPTH, D_MODEL, D_FF), D_MODEL ** -0.5),
        'ffn_w_down': nrm(ks[23], (DEPTH, D_FF, D_MODEL), D_FF ** -0.5),
        'final_norm_w': 1.0 + nrm(ks[24], (D_MODEL,), 0.02),
    }


def reference(x, c, ctx, c_ctx, ada_w, ada_b, norm_w, even_w_in, even_w_out, ret_decay_logit,
              conv_dw_w, conv_ln_w, conv_ln_b, odd_w_in, odd_w_out, pool_w, pool_scale,
              sg_ln_w, sg_ln_b, sg_w, sg_b, ffn_w_gate, ffn_w_up, ffn_w_down, final_norm_w):
    b, l, d = x.shape
    lc = ctx.shape[1]
    rows = l // GRID_W
    grid_r = jnp.broadcast_to(jnp.arange(rows, dtype=jnp.float32)[:, None], (rows, GRID_W)).reshape(-1)
    grid_c = jnp.broadcast_to(jnp.arange(GRID_W, dtype=jnp.float32)[None, :], (rows, GRID_W)).reshape(-1)
    ang_x = rope_angles(jnp.full((l,), lc, jnp.float32), grid_r, grid_c)
    zeros_c = jnp.zeros((lc,), jnp.float32)
    ang_c = rope_angles(jnp.arange(lc, dtype=jnp.float32), zeros_c, zeros_c)
    silu_c = jax.nn.silu(c)
    silu_cc = jax.nn.silu(c_ctx)

    for i in range(DEPTH):
        j = i // 2
        even = i % 2 == 0
        ctx_after = any(m % 2 == 0 for m in range(i + 1, DEPTH))
        use_ctx = even or ctx_after
        mod_x = (silu_c @ ada_w[i] + ada_b[i]).reshape(b, 6, 1, d)
        hx = modulate(rms_norm(x, norm_w[i, 0]), mod_x[:, 0], mod_x[:, 1])
        if use_ctx:
            mod_c = (silu_cc @ ada_w[i] + ada_b[i]).reshape(6, 1, d)
            hc = modulate(rms_norm(ctx, norm_w[i, 0]), mod_c[0], mod_c[1])
        if even:
            log_g2 = jax.nn.log_sigmoid(ret_decay_logit[j].astype(jnp.float32))
            if ctx_after:
                parts_c = even_project(hc, even_w_in[j], ang_c)
                kc, vc = parts_c[1], parts_c[2]
            else:
                kc, vc = retention_kv(hc, even_w_in[j], ang_c)
            s_f, s_b = retention_final_states(kc, vc, log_g2)
            yx = even_mix(*even_project(hx, even_w_in[j], ang_x), s_f, s_b, log_g2,
                          conv_dw_w[j], conv_ln_w[j], conv_ln_b[j], even_w_out[j])
            if ctx_after:
                s_zero = jnp.zeros_like(s_f)
                yc = even_mix(*parts_c, s_zero, s_zero, log_g2,
                              conv_dw_w[j], conv_ln_w[j], conv_ln_b[j], even_w_out[j])
        else:
            yx = odd_stream(hx, odd_w_in[j], odd_w_out[j], pool_w[j], pool_scale[j],
                            sg_ln_w[j], sg_ln_b[j], sg_w[j], sg_b[j])
            if ctx_after:
                yc = odd_stream(hc, odd_w_in[j], odd_w_out[j], pool_w[j], pool_scale[j],
                                sg_ln_w[j], sg_ln_b[j], sg_w[j], sg_b[j])
        x = x + mod_x[:, 2] * yx
        x = x + mod_x[:, 5] * swiglu(modulate(rms_norm(x, norm_w[i, 1]), mod_x[:, 3], mod_x[:, 4]),
                                     ffn_w_gate[i], ffn_w_up[i], ffn_w_down[i])
        if ctx_after:
            ctx = ctx + mod_c[2] * yc
            ctx = ctx + mod_c[5] * swiglu(modulate(rms_norm(ctx, norm_w[i, 1]), mod_c[3], mod_c[4]),
                                          ffn_w_gate[i], ffn_w_up[i], ffn_w_down[i])
    return rms_norm(x, final_norm_w)
```

```cpp
#include <hip/hip_runtime.h>
#include <hip/hip_cooperative_groups.h>
#include <cstdio>
namespace cg = cooperative_groups;
namespace pg8 {
#define PG8_LAS __attribute__((address_space(3)))
typedef unsigned short bf16_t;
typedef short bf16x8 __attribute__((ext_vector_type(8)));
typedef float f32x4 __attribute__((ext_vector_type(4)));
typedef unsigned u32x4 __attribute__((ext_vector_type(4)));
constexpr int BM = 256, BK = 64, HALF = 128, HTB = HALF * BK * 2  , STAGE_BYTES = 8 * HTB, NXCD = 8, WGM = 8;

__host__ __device__ __forceinline__ int lds_byte(int r, int c) { const int st = (r >> 4) * 2 + (c >> 5), rr = r & 15, cc = c & 31, ob = rr * 64 + cc * 2; return st * 1024 + (ob ^ (((ob >> 9) & 1) << 5)); }
__host__ __device__ __forceinline__ void stage_rc(int b, int& R, int& C) { const int st = b / 1024, sb = b % 1024, swz = sb ^ (((sb >> 9) & 1) << 5); R = (st >> 1) * 16 + swz / 64; C = (st & 1) * 32 + (swz % 64) / 2; }
__host__ __device__ __forceinline__ int perm32(int rho) { const int n = rho >> 4, i = rho & 15; return 8 * (i >> 2) + 4 * n + (i & 3); }

struct Unit { int pm, pn; };
struct Gemm { const bf16_t* A; const bf16_t* Bt; int M, N, K; };

struct StaticOrder {
    int nM, nN, nwg, G, c;
    __host__ __device__ void init(int M, int N, int G_, int c_) { nM = M / BM; nN = N / BM; nwg = nM * nN; G = G_; c = c_; }
    __host__ __device__ bool next(int i, Unit& u) const {
        const long L = (long)i * G + c; if (L >= nwg) return false;
        int wgid = (int)L; { const int q = nwg / NXCD, r = nwg % NXCD, xcd = wgid % NXCD, off = wgid / NXCD; wgid = (xcd < r ? xcd * (q + 1) : r * (q + 1) + (xcd - r) * q) + off; }
        const int nig = WGM * nN, gid = wgid / nig, fm = gid * WGM, gsz = (nM - fm) < WGM ? (nM - fm) : WGM;
        u.pm = fm + ((wgid % nig) % gsz); u.pn = (wgid % nig) / gsz; return true;
    }
    __device__ __forceinline__ void a_ready(const Unit&) const {}
    __device__ __forceinline__ void done(const Unit&) const {}
};
__device__ __forceinline__ unsigned cvt_pk_bf16(float lo, float hi) { unsigned r; asm volatile("v_cvt_pk_bf16_f32 %0, %1, %2" : "=v"(r) : "v"(lo), "v"(hi)); return r; }
typedef float f32x2 __attribute__((ext_vector_type(2)));
__device__ __forceinline__ f32x2 gelu_pk(f32x2 v) {
    const f32x2 av = __builtin_elementwise_abs(v), d = av * 0.2316418882f + 1.0f;
    f32x2 t; t.x = __builtin_amdgcn_rcpf(d.x); t.y = __builtin_amdgcn_rcpf(d.y);
    f32x2 q = t * 0.5307027145f + (-0.7265760135f); q = q * t + 0.7107068705f; q = q * t + (-0.142248368f); q = q * t + 0.127414796f; q = q * t;
    const f32x2 s = (v * v) * (-0.72134752044f);
    f32x2 e; e.x = __builtin_amdgcn_exp2f(s.x); e.y = __builtin_amdgcn_exp2f(s.y);
    const f32x2 m = v * (q * e), r = v - m;
    f32x2 o; o.x = v.x < 0.f ? m.x : r.x; o.y = v.y < 0.f ? m.y : r.y; return o;
}

template <class Epi, class Sched, bool STAMP = false>
__device__ __forceinline__ void gemm_phase(PG8_LAS unsigned char* lds, const Gemm g, const Sched& S, const Epi& E, unsigned long long* stamps) {
    int tid_ = threadIdx.x; asm volatile("" : "+v"(tid_)); const int tid = tid_, wid = __builtin_amdgcn_readfirstlane(tid >> 6), lane = tid & 63, wr = wid >> 2, wc = wid & 3, fr = lane & 15, fq = lane >> 4;
    const int K = g.K, nt = K / BK;
    int ts_lo = 0, ts_hi = 0, nts = 0; const unsigned long long rt_entry = STAMP ? (unsigned long long)wall_clock64() : 0ull;
#define PG8_STAMP() do { if (STAMP && wid == 0 && nts < 64) { const unsigned long long _c = (unsigned long long)clock64(); \
        ts_lo = (lane == nts) ? (int)(unsigned)_c : ts_lo; ts_hi = (lane == nts) ? (int)(unsigned)(_c >> 32) : ts_hi; ++nts; } } while (0)
    PG8_STAMP();
    unsigned voffA[2], voffB[2];
#pragma unroll
    for (int i = 0; i < 2; ++i) { int R, C; stage_rc(tid * 16 + i * 8192, R, C); const int Rb = Epi::PERM ? ((R & ~31) + perm32(R & 31)) : R;
        voffA[i] = (unsigned)(R * K + C) * 2u; voffB[i] = (unsigned)(Rb * K + C) * 2u; }
    const size_t kstep = (size_t)(BK * 2);
    const size_t hstep = (size_t)HALF * K * 2;
    const size_t tstep = 2 * hstep;
    const unsigned ldsw = (unsigned)wid * 1024u;
    const int aoff = lds_byte(wr * 64 + fr, fq * 8), boff = lds_byte(wc * 32 + fr, fq * 8);
#define PG8_SA(b, h) (((b) * 2 + (h)) * HTB)
#define PG8_SB(b, h) ((4 + (b) * 2 + (h)) * HTB)
#define PG8_STAGE(bufoff, gbase, voff) do { _Pragma("unroll") for (int _i = 0; _i < 2; ++_i) \
        __builtin_amdgcn_global_load_lds((const unsigned*)((const char*)(gbase) + (voff)[_i]), (PG8_LAS unsigned*)(lds + (bufoff) + ldsw + _i * 8192), 16, 0, 0); } while (0)
#define PG8_LDA(dst, b, h) do { _Pragma("unroll") for (int m = 0; m < 4; ++m) _Pragma("unroll") for (int k = 0; k < 2; ++k) dst[m][k] = *(const PG8_LAS bf16x8*)(lds + PG8_SA(b, h) + aoff + m * 2048 + k * 1024); } while (0)
#define PG8_LDB(dst, b, h) do { _Pragma("unroll") for (int n = 0; n < 2; ++n) _Pragma("unroll") for (int k = 0; k < 2; ++k) dst[n][k] = *(const PG8_LAS bf16x8*)(lds + PG8_SB(b, h) + boff + n * 2048 + k * 1024); } while (0)
#define PG8_MMA(ai, bj, At, Bt) do { __builtin_amdgcn_s_setprio(1); _Pragma("unroll") for (int m = 0; m < 4; ++m) _Pragma("unroll") for (int n = 0; n < 2; ++n) _Pragma("unroll") for (int k = 0; k < 2; ++k) \
        acc[ai][bj][m][n] = __builtin_amdgcn_mfma_f32_16x16x32_bf16(Bt[n][k], At[m][k], acc[ai][bj][m][n], 0, 0, 0); __builtin_amdgcn_s_setprio(0); } while (0)
#define PG8_WAIT_V(n) asm volatile("s_waitcnt vmcnt(" #n ")" ::: "memory")
#define PG8_WAIT_L(n) asm volatile("s_waitcnt lgkmcnt(" #n ")" ::: "memory")
#define PG8_BAR __builtin_amdgcn_s_barrier()
#define PG8_SCHED __builtin_amdgcn_sched_barrier(0)
    Unit cur, nxt; int ui = 0;
    if (!S.next(0, cur)) return;
    f32x4 acc[2][2][4][2];
#pragma unroll
    for (int a = 0; a < 2; ++a)
#pragma unroll
        for (int b = 0; b < 2; ++b)
#pragma unroll
            for (int m = 0; m < 4; ++m)
#pragma unroll
                for (int n = 0; n < 2; ++n) acc[a][b][m][n] = (f32x4){0.f, 0.f, 0.f, 0.f};
    bf16x8 At[4][2], B0[2][2], B1[2][2];
    const char* cA = (const char*)g.A + (size_t)cur.pm * tstep; const char* cB = (const char*)g.Bt + (size_t)cur.pn * tstep;
    S.a_ready(cur);
    PG8_STAGE(PG8_SB(0, 0), cB, voffB); PG8_STAGE(PG8_SA(0, 0), cA, voffA); PG8_STAGE(PG8_SB(0, 1), cB + hstep, voffB); PG8_STAGE(PG8_SA(0, 1), cA + hstep, voffA);
    if (wr == 1) PG8_BAR;
    PG8_WAIT_V(4); PG8_BAR;
    PG8_STAGE(PG8_SB(1, 0), cB + kstep, voffB); PG8_STAGE(PG8_SA(1, 0), cA + kstep, voffA); PG8_STAGE(PG8_SB(1, 1), cB + hstep + kstep, voffB);
    PG8_WAIT_V(6); PG8_BAR;
    PG8_STAMP();
    for (;;) {
        const bool has_next = S.next(ui + 1, nxt);
        const char* nA = has_next ? (const char*)g.A + (size_t)nxt.pm * tstep : cA; const char* nB = has_next ? (const char*)g.Bt + (size_t)nxt.pn * tstep : cB;
        for (int t = 0; t < nt; t += 2) {
            const bool last = (t == nt - 2);
            const char* a1 = cA + (size_t)(t + 1) * kstep;
            const char* a2 = last ? nA : cA + (size_t)(t + 2) * kstep; const char* b2 = last ? nB : cB + (size_t)(t + 2) * kstep;
            const char* a3 = a2 + kstep; const char* b3 = b2 + kstep;
            if (last && has_next) S.a_ready(nxt);
            PG8_LDB(B0, 0, 0); PG8_SCHED; PG8_LDA(At, 0, 0); PG8_STAGE(PG8_SA(1, 1), a1 + hstep, voffA);
            PG8_WAIT_L(8); PG8_BAR; PG8_WAIT_L(0); PG8_MMA(0, 0, At, B0); PG8_BAR; PG8_SCHED;
            PG8_LDB(B1, 0, 1); PG8_STAGE(PG8_SB(0, 0), b2, voffB);
            PG8_BAR; PG8_WAIT_L(0); PG8_MMA(0, 1, At, B1); PG8_BAR;
            PG8_LDA(At, 0, 1); PG8_STAGE(PG8_SA(0, 0), a2, voffA);
            PG8_BAR; PG8_WAIT_L(0); PG8_MMA(1, 0, At, B0); PG8_BAR; PG8_SCHED;
            PG8_STAGE(PG8_SB(0, 1), b2 + hstep, voffB);
            PG8_WAIT_V(6); PG8_BAR; PG8_MMA(1, 1, At, B1); PG8_BAR;
            PG8_LDB(B0, 1, 0); PG8_SCHED; PG8_LDA(At, 1, 0); PG8_STAGE(PG8_SA(0, 1), a2 + hstep, voffA);
            PG8_WAIT_L(8); PG8_BAR; PG8_WAIT_L(0); PG8_MMA(0, 0, At, B0); PG8_BAR; PG8_SCHED;
            PG8_LDB(B1, 1, 1); PG8_STAGE(PG8_SB(1, 0), b3, voffB);
            PG8_BAR; PG8_WAIT_L(0); PG8_MMA(0, 1, At, B1); PG8_BAR;
            PG8_LDA(At, 1, 1); PG8_STAGE(PG8_SA(1, 0), a3, voffA);
            PG8_BAR; PG8_WAIT_L(0); PG8_MMA(1, 0, At, B0); PG8_BAR; PG8_SCHED;
            PG8_STAGE(PG8_SB(1, 1), b3 + hstep, voffB);
            PG8_WAIT_V(6); PG8_BAR; PG8_MMA(1, 1, At, B1); PG8_BAR;
        }
        PG8_STAMP();
        if constexpr (!Epi::AFTER_DRAIN) { E(acc, cur, wr, wc, fr, fq); S.done(cur); }
        PG8_STAMP();
        if (!has_next) break;
#pragma unroll
        for (int a = 0; a < 2; ++a)
#pragma unroll
            for (int b = 0; b < 2; ++b)
#pragma unroll
                for (int m = 0; m < 4; ++m)
#pragma unroll
                    for (int n = 0; n < 2; ++n) acc[a][b][m][n] = (f32x4){0.f, 0.f, 0.f, 0.f};
        cur = nxt; cA = nA; cB = nB; ++ui;
    }
    PG8_WAIT_V(0);
    if (wr == 0) PG8_BAR;
    PG8_BAR;
    if constexpr (Epi::AFTER_DRAIN) { E.fused(acc, cur, wr, wc, fr, fq, lds, wid, lane); S.done(cur); }
    PG8_STAMP();
    if (STAMP && wid == 0) { stamps[lane] = lane < nts ? (((unsigned long long)(unsigned)ts_hi << 32) | (unsigned)ts_lo) : 0ull;
        if (lane == 62) stamps[62] = rt_entry; if (lane == 63) stamps[63] = (unsigned long long)wall_clock64(); }
#undef PG8_STAMP
#undef PG8_SA
#undef PG8_SB
#undef PG8_STAGE
#undef PG8_LDA
#undef PG8_LDB
#undef PG8_MMA
#undef PG8_WAIT_V
#undef PG8_WAIT_L
#undef PG8_BAR
#undef PG8_SCHED
}
}

namespace mk {
using pg8::bf16_t; using pg8::bf16x8; using pg8::f32x4; using pg8::u32x4; using pg8::f32x2; using pg8::Unit;
#define DI __device__ __forceinline__
#define LAS __attribute__((address_space(3)))
typedef LAS unsigned char* ldsp;
typedef unsigned u32x2 __attribute__((ext_vector_type(2)));

constexpr int D = 1024, NLAT = 16384, MTOT = 17408, DFF = 2816;
constexpr float EPS = 1e-6f;
constexpr float LOG2E = 1.4426950408889634f;

constexpr size_t SZ_HALF = (size_t)MTOT * 512 * 2;
constexpr size_t WS_XR = 0;
constexpr size_t WS_H = WS_XR + (size_t)MTOT * D * 4;
constexpr size_t WS_P = WS_H + (size_t)MTOT * D * 2;
constexpr size_t WS_MIX = WS_P + 5 * SZ_HALF;
constexpr size_t WS_KV = WS_MIX + (size_t)MTOT * D * 2;
constexpr size_t WS_WB = WS_KV + (size_t)16 * 34 * 2 * 16384 * 4;
constexpr size_t WB_IN = 0, WB_OUT = (size_t)3072 * 1024 * 2, WB_GU = WB_OUT + (size_t)1024 * 1024 * 2, WB_DN = WB_GU + (size_t)5632 * 1024 * 2, WB_END = WB_DN + (size_t)1024 * 2816 * 2;
constexpr size_t WS_MOD = WS_WB + WB_END;
constexpr size_t WS_ROPE = WS_MOD + (size_t)4 * 5 * 6144 * 4;
constexpr size_t WS_SGW = WS_ROPE + (size_t)2 * 4352 * 64 * 4;
constexpr size_t WS_PWT = WS_SGW + (size_t)2 * 4 * 128 * 128 * 2;
constexpr size_t WS_END = WS_PWT + (size_t)2 * 4 * 128 * 128 * 2;
static_assert((size_t)MTOT * DFF * 2 <= WS_KV - WS_P, "ACT alias");
constexpr int LDS_BYTES = 4 * 128 * 136 * 2;

struct Params {
    const float *x, *c, *ctx, *c_ctx, *ada_w, *ada_b, *norm_w, *even_w_in, *even_w_out, *ret_decay, *conv_w, *conv_ln_w, *conv_ln_b,
        *odd_w_in, *odd_w_out, *pool_w, *pool_scale, *sg_ln_w, *sg_ln_b, *sg_w, *sg_b, *ffn_gate, *ffn_up, *ffn_down, *final_w;
    float* out; unsigned char* ws;
};

DI int opaque_tid() { int t = threadIdx.x; asm volatile("" : "+v"(t)); return t; }
DI unsigned short f2bf(float f) { unsigned u = __float_as_uint(f); u += 0x7fffu + ((u >> 16) & 1u); return (unsigned short)(u >> 16); }
DI unsigned pack2(float lo, float hi) { return (unsigned)f2bf(lo) | ((unsigned)f2bf(hi) << 16); }
DI float bflo(unsigned u) { return __uint_as_float(u << 16); }
DI float bfhi(unsigned u) { return __uint_as_float(u & 0xffff0000u); }
DI float bf1(unsigned short u) { return __uint_as_float((unsigned)u << 16); }
DI float silu_f(float v) { return v / (1.0f + __expf(-v)); }
DI float sigm_f(float v) { return 1.0f / (1.0f + __expf(-v)); }
DI f32x4 mma(bf16x8 y, bf16x8 x, f32x4 c) { return __builtin_amdgcn_mfma_f32_16x16x32_bf16(y, x, c, 0, 0, 0); }
DI float log2_decay(const float* logit) { const float x = *logit; return -log1pf(expf(-x)) * LOG2E; }
DI float wave_sum(float v) { for (int o = 32; o >= 1; o >>= 1) v += __shfl_xor(v, o); return v; }
DI int mod_set(int row) { return row < NLAT ? (row >> 12) : 4; }

struct EpiEvenIn {
    static constexpr bool PERM = true, AFTER_DRAIN = false;
    bf16_t *Q, *K, *V, *G, *U; const float* rope;
    DI void operator()(const f32x4 (&acc)[2][2][4][2], const Unit& u, int wr, int wc, int fr, int fq) const {
        const int row0 = u.pm * 256 + wr * 64 + fr, colb = u.pn * 256 + wc * 32 + 8 * fq, region = u.pn >> 1;
#pragma unroll
        for (int ai = 0; ai < 2; ++ai)
#pragma unroll
            for (int m = 0; m < 4; ++m) {
                const int row = row0 + ai * 128 + m * 16;
                const int pi = row < NLAT ? (row & 4095) : 4096 + ((row - NLAT) & 255);
#pragma unroll
                for (int bj = 0; bj < 2; ++bj) {
                    const int c0 = colb + bj * 128; const f32x4 v0 = acc[ai][bj][m][0], v1 = acc[ai][bj][m][1];
                    if (region < 2) {
                        const int hc = c0 & 511, head = hc >> 7, d = ((hc & 127) >> 3) * 4;
                        const f32x4 cs = *(const f32x4*)(rope + (size_t)pi * 64 + d), sn = *(const f32x4*)(rope + (size_t)4352 * 64 + (size_t)pi * 64 + d);
                        const float sc = region == 0 ? 0.08838834764831845f : 1.0f;
                        const f32x4 o1 = (v0 * cs - v1 * sn) * sc, o2 = (v0 * sn + v1 * cs) * sc;
                        bf16_t* dst = (region == 0 ? Q : K) + (size_t)row * 512 + head * 128 + d;
                        u32x2 w1, w2; w1.x = pg8::cvt_pk_bf16(o1[0], o1[1]); w1.y = pg8::cvt_pk_bf16(o1[2], o1[3]); w2.x = pg8::cvt_pk_bf16(o2[0], o2[1]); w2.y = pg8::cvt_pk_bf16(o2[2], o2[3]);
                        *(u32x2*)dst = w1; *(u32x2*)(dst + 64) = w2;
                    } else if (region < 4) {
                        bf16_t* dst = (region == 2 ? V : G) + (size_t)row * 512 + (c0 & 511);
                        u32x4 w; w.x = pg8::cvt_pk_bf16(v0[0], v0[1]); w.y = pg8::cvt_pk_bf16(v0[2], v0[3]); w.z = pg8::cvt_pk_bf16(v1[0], v1[1]); w.w = pg8::cvt_pk_bf16(v1[2], v1[3]);
                        *(u32x4*)dst = w;
                    } else {
                        const int gi = (c0 - 2048) >> 3;
                        u32x2 w; w.x = pg8::cvt_pk_bf16(v0[0] * sigm_f(v1[0]), v0[1] * sigm_f(v1[1])); w.y = pg8::cvt_pk_bf16(v0[2] * sigm_f(v1[2]), v0[3] * sigm_f(v1[3]));
                        *(u32x2*)(U + (size_t)row * 512 + 4 * gi) = w;
                    }
                }
            }
    }
};
struct EpiOddIn {
    static constexpr bool PERM = true, AFTER_DRAIN = false;
    bf16_t *PC, *Z;
    DI void operator()(const f32x4 (&acc)[2][2][4][2], const Unit& u, int wr, int wc, int fr, int fq) const {
        const int row0 = u.pm * 256 + wr * 64 + fr, colb = u.pn * 256 + wc * 32 + 8 * fq; const bool is_pc = u.pn < 2;
#pragma unroll
        for (int ai = 0; ai < 2; ++ai)
#pragma unroll
            for (int m = 0; m < 4; ++m) {
                const int row = row0 + ai * 128 + m * 16;
#pragma unroll
                for (int bj = 0; bj < 2; ++bj) {
                    const int c0 = colb + bj * 128; f32x4 v0 = acc[ai][bj][m][0], v1 = acc[ai][bj][m][1];
                    bf16_t* dst;
                    if (is_pc) dst = PC + (size_t)row * 512 + c0;
                    else { const f32x2 a = pg8::gelu_pk((f32x2){v0[0], v0[1]}), b = pg8::gelu_pk((f32x2){v0[2], v0[3]}), c = pg8::gelu_pk((f32x2){v1[0], v1[1]}), d = pg8::gelu_pk((f32x2){v1[2], v1[3]});
                        v0 = (f32x4){a.x, a.y, b.x, b.y}; v1 = (f32x4){c.x, c.y, d.x, d.y}; dst = Z + (size_t)row * 1024 + (c0 - 512); }
                    u32x4 w; w.x = pg8::cvt_pk_bf16(v0[0], v0[1]); w.y = pg8::cvt_pk_bf16(v0[2], v0[3]); w.z = pg8::cvt_pk_bf16(v1[0], v1[1]); w.w = pg8::cvt_pk_bf16(v1[2], v1[3]);
                    *(u32x4*)dst = w;
                }
            }
    }
};
struct EpiGU {
    static constexpr bool PERM = true, AFTER_DRAIN = false;
    bf16_t* ACT;
    DI void operator()(const f32x4 (&acc)[2][2][4][2], const Unit& u, int wr, int wc, int fr, int fq) const {
        const int row0 = u.pm * 256 + wr * 64 + fr, colb = u.pn * 256 + wc * 32 + 8 * fq;
#pragma unroll
        for (int ai = 0; ai < 2; ++ai)
#pragma unroll
            for (int m = 0; m < 4; ++m) {
                const int row = row0 + ai * 128 + m * 16;
#pragma unroll
                for (int bj = 0; bj < 2; ++bj) {
                    const int gi = (colb + bj * 128) >> 3; const f32x4 v0 = acc[ai][bj][m][0], v1 = acc[ai][bj][m][1];
                    u32x2 w; w.x = pg8::cvt_pk_bf16(silu_f(v0[0]) * v1[0], silu_f(v0[1]) * v1[1]); w.y = pg8::cvt_pk_bf16(silu_f(v0[2]) * v1[2], silu_f(v0[3]) * v1[3]);
                    *(u32x2*)(ACT + (size_t)row * DFF + 4 * gi) = w;
                }
            }
    }
};
struct EpiRes {
    static constexpr bool PERM = false, AFTER_DRAIN = false;
    float* X; const float* gate;
    DI void operator()(const f32x4 (&acc)[2][2][4][2], const Unit& u, int wr, int wc, int fr, int fq) const {
        const int row0 = u.pm * 256 + wr * 64 + fr, col0 = u.pn * 256 + wc * 32 + 4 * fq;
        const float* gp = gate + (size_t)(u.pm < 64 ? (u.pm >> 4) : 4) * 6144 + col0;
        f32x4 gv[2][2];
#pragma unroll
        for (int bj = 0; bj < 2; ++bj)
#pragma unroll
            for (int n = 0; n < 2; ++n) gv[bj][n] = *(const f32x4*)(gp + bj * 128 + n * 16);
#pragma unroll
        for (int ai = 0; ai < 2; ++ai)
#pragma unroll
            for (int m = 0; m < 4; ++m) { float* rowp = X + (size_t)(row0 + ai * 128 + m * 16) * D + col0;
#pragma unroll
                for (int bj = 0; bj < 2; ++bj)
#pragma unroll
                    for (int n = 0; n < 2; ++n) { f32x4* p = (f32x4*)(rowp + bj * 128 + n * 16); *p = *p + gv[bj][n] * acc[ai][bj][m][n]; } }
    }
};

template <class Epi> DI void run_gemm(ldsp lds, const bf16_t* A, const bf16_t* Bt, int M, int N, int K, const Epi& E) {
    pg8::Gemm g{A, Bt, M, N, K}; pg8::StaticOrder S; S.init(M, N, (int)gridDim.x, (int)blockIdx.x);
    pg8::gemm_phase<Epi, pg8::StaticOrder, false>(lds, g, S, E, nullptr);
}

DI void ph_init(const Params& P, ldsp lds) {
    const int tid = opaque_tid(), G = gridDim.x, bid = blockIdx.x;
    float* mod = (float*)(P.ws + WS_MOD);
    LAS float* sc = (LAS float*)lds;
    LAS float* red = (LAS float*)(lds + 5 * 1024 * 4);
    if (bid < 192) {
        for (int idx = tid; idx < 5120; idx += 512) { const int s = idx >> 10, k = idx & 1023; const float v = s < 4 ? P.c[s * 1024 + k] : P.c_ctx[k]; sc[idx] = silu_f(v); }
        __syncthreads();
        for (int u = bid; u < 192; u += G) {
            const int l = u / 48, cb = u % 48, cc = tid & 127, kq = tid >> 7;
            const float* wp = P.ada_w + ((size_t)l * 1024 + kq * 256) * 6144 + cb * 128 + cc;
            float a0 = 0.f, a1 = 0.f, a2 = 0.f, a3 = 0.f, a4 = 0.f;
#pragma unroll 8
            for (int k = 0; k < 256; ++k) { const float w = wp[(size_t)k * 6144]; const int kk = kq * 256 + k;
                a0 += sc[kk] * w; a1 += sc[1024 + kk] * w; a2 += sc[2048 + kk] * w; a3 += sc[3072 + kk] * w; a4 += sc[4096 + kk] * w; }
            red[(kq * 5 + 0) * 128 + cc] = a0; red[(kq * 5 + 1) * 128 + cc] = a1; red[(kq * 5 + 2) * 128 + cc] = a2; red[(kq * 5 + 3) * 128 + cc] = a3; red[(kq * 5 + 4) * 128 + cc] = a4;
            __syncthreads();
            for (int idx = tid; idx < 640; idx += 512) { const int s = idx >> 7, c2 = idx & 127;
                const float v = red[(0 * 5 + s) * 128 + c2] + red[(1 * 5 + s) * 128 + c2] + red[(2 * 5 + s) * 128 + c2] + red[(3 * 5 + s) * 128 + c2] + P.ada_b[l * 6144 + cb * 128 + c2];
                mod[((size_t)l * 5 + s) * 6144 + cb * 128 + c2] = v; }
            __syncthreads();
        }
    }
    { const f32x4* x4 = (const f32x4*)P.x; const f32x4* c4 = (const f32x4*)P.ctx; f32x4* o4 = (f32x4*)(P.ws + WS_XR);
      for (int idx = bid * 512 + tid; idx < MTOT * 256; idx += G * 512) o4[idx] = idx < NLAT * 256 ? x4[idx] : c4[idx - NLAT * 256]; }
    { float* rc = (float*)(P.ws + WS_ROPE); float* rs = rc + 4352 * 64;
      for (int idx = bid * 512 + tid; idx < 4352 * 64; idx += G * 512) { const int pi = idx >> 6, d = idx & 63;
          float ps, pr, pc; if (pi < 4096) { ps = 256.f; pr = (float)(pi >> 6); pc = (float)(pi & 63); } else { ps = (float)(pi - 4096); pr = 0.f; pc = 0.f; }
          float ang; if (d < 16) ang = ps * powf(10000.f, -(float)d / 16.f); else if (d < 40) ang = pr * powf(10000.f, -(float)(d - 16) / 24.f); else ang = pc * powf(10000.f, -(float)(d - 40) / 24.f);
          float sv, cv; sincosf(ang, &sv, &cv); rc[idx] = cv; rs[idx] = sv; } }
    { bf16_t* sgw = (bf16_t*)(P.ws + WS_SGW); bf16_t* pwt = (bf16_t*)(P.ws + WS_PWT);
      for (int idx = bid * 512 + tid; idx < 2 * 4 * 128 * 128; idx += G * 512) { sgw[idx] = f2bf(P.sg_w[idx]);
          const int jg = idx >> 14, dd = (idx >> 7) & 127, cc = idx & 127; pwt[idx] = f2bf(P.pool_w[(size_t)jg * 16384 + cc * 128 + dd]); } }
}

DI const float* src_col(int mode, int p, const float* a, const float* b) {
    if (mode == 0) return a + p;
    if (mode == 1) {
        if (p < 1024) { const int j = p & 127, g8 = j >> 3, e = j & 7; return a + (p & ~127) + (e < 4 ? 4 * g8 + e : 64 + 4 * g8 + (e - 4)); }
        if (p < 2048) return a + p;
        const int jj = p - 2048, g8 = jj >> 3, e = jj & 7; return a + (e < 4 ? 2048 + 4 * g8 + e : 2560 + 4 * g8 + (e - 4));
    }
    const int g8 = p >> 3, e = p & 7; return e < 4 ? a + 4 * g8 + e : b + 4 * g8 + (e - 4);
}
DI void convert_w(ldsp lds, bf16_t* dst, int K, int Np, int ld, int mode, const float* a, const float* b, int& tile_ctr) {
    LAS float* tile = (LAS float*)lds;
    const int G = gridDim.x, npt = Np / 64, nkt = K / 64, ntiles = npt * nkt;
    int first = ((int)blockIdx.x - tile_ctr % G + G) % G;
    for (int t = first; t < ntiles; t += G) {
        const int pt = t % npt, kt = t / npt, p0 = pt * 64, k0 = kt * 64; const int tid = opaque_tid();
        { const int pp = tid & 63, kk = tid >> 6; const float* col = src_col(mode, p0 + pp, a, b);
#pragma unroll
          for (int i = 0; i < 8; ++i) { const int k = kk + 8 * i; tile[k * 65 + pp] = col[(size_t)(k0 + k) * ld]; } }
        __syncthreads();
        { const int kp = tid & 31, pr = tid >> 5;
#pragma unroll
          for (int i = 0; i < 4; ++i) { const int p = pr + 16 * i; *(unsigned*)(dst + (size_t)(p0 + p) * K + k0 + 2 * kp) = pack2(tile[(2 * kp) * 65 + p], tile[(2 * kp + 1) * 65 + p]); } }
        __syncthreads();
    }
    tile_ctr += ntiles;
}

DI void ph_norm(const Params& P, ldsp lds, int layer, int which, int M, bool conv) {
    const int tid = opaque_tid(), lane = tid & 63, wv = tid >> 6, G = gridDim.x;
    const float* xr = (const float*)(P.ws + WS_XR); bf16_t* H = (bf16_t*)(P.ws + WS_H);
    const float* mod = (const float*)(P.ws + WS_MOD) + (size_t)layer * 5 * 6144 + which * 3 * 1024;
    const float* nw = P.norm_w + ((size_t)layer * 2 + which) * 1024;
    for (int row = blockIdx.x * 8 + wv; row < M; row += G * 8) {
        const f32x4* xp = (const f32x4*)(xr + (size_t)row * D); f32x4 v[4]; float ss = 0.f;
#pragma unroll
        for (int j = 0; j < 4; ++j) { v[j] = xp[j * 64 + lane]; ss += v[j][0] * v[j][0] + v[j][1] * v[j][1] + v[j][2] * v[j][2] + v[j][3] * v[j][3]; }
        ss = wave_sum(ss); const float rstd = rsqrtf(ss * (1.0f / 1024.0f) + EPS);
        const float* ms = mod + (size_t)mod_set(row) * 6144;
#pragma unroll
        for (int j = 0; j < 4; ++j) { const int c = (j * 64 + lane) * 4; const f32x4 w = *(const f32x4*)(nw + c), sh = *(const f32x4*)(ms + c), scl = *(const f32x4*)(ms + 1024 + c);
            const f32x4 h = (v[j] * rstd * w) * (scl + 1.0f) + sh; u32x2 o; o.x = pack2(h[0], h[1]); o.y = pack2(h[2], h[3]); *(u32x2*)(H + (size_t)row * D + c) = o; }
    }
    if (conv) {
        unsigned char* wb = P.ws + WS_WB; const int j = layer >> 1; int ctr = 0;
        if (!(layer & 1)) { convert_w(lds, (bf16_t*)(wb + WB_IN), 1024, 3072, 3072, 1, P.even_w_in + (size_t)j * 1024 * 3072, nullptr, ctr);
                            convert_w(lds, (bf16_t*)(wb + WB_OUT), 1024, 1024, 1024, 0, P.even_w_out + (size_t)j * 1024 * 1024, nullptr, ctr); }
        else { convert_w(lds, (bf16_t*)(wb + WB_IN), 1024, 1536, 1536, 0, P.odd_w_in + (size_t)j * 1024 * 1536, nullptr, ctr);
               convert_w(lds, (bf16_t*)(wb + WB_OUT), 1024, 1024, 1024, 0, P.odd_w_out + (size_t)j * 1024 * 1024, nullptr, ctr); }
        convert_w(lds, (bf16_t*)(wb + WB_GU), 1024, 5632, 2816, 2, P.ffn_gate + (size_t)layer * 1024 * 2816, P.ffn_up + (size_t)layer * 1024 * 2816, ctr);
        convert_w(lds, (bf16_t*)(wb + WB_DN), 2816, 1024, 1024, 0, P.ffn_down + (size_t)layer * 2816 * 1024, nullptr, ctr);
    }
}

DI int chunk_row0(int b, int chunk) { return chunk < 2 ? NLAT + b * 256 + chunk * 128 : b * 4096 + (chunk - 2) * 128; }
DI void ret_kv_unit(const Params& P, ldsp lds, int j, int unit) {
    const int tid = opaque_tid(), lane = tid & 63, wv = tid >> 6, r = lane & 15, q = lane >> 4;
    const int bh = unit / 34, chunk = unit % 34, b = bh >> 2, h = bh & 3, row0 = chunk_row0(b, chunk);
    const float l2f = log2_decay(P.ret_decay + j * 8 + h), l2b = log2_decay(P.ret_decay + j * 8 + 4 + h);
    const bf16_t* Kb = (const bf16_t*)(P.ws + WS_P + SZ_HALF); const bf16_t* Vb = (const bf16_t*)(P.ws + WS_P + 2 * SZ_HALF);
    LAS unsigned short* KT = (LAS unsigned short*)lds; LAS unsigned short* VTf = KT + 128 * 136; LAS unsigned short* VTb = VTf + 128 * 136;
    { const int m = tid & 127, dq = tid >> 7; const float zf = exp2f(l2f * (float)(127 - m)), zb = exp2f(l2b * (float)m);
#pragma unroll
      for (int c4 = 0; c4 < 4; ++c4) { const int d0 = (dq * 4 + c4) * 8; const size_t go = (size_t)(row0 + m) * 512 + h * 128 + d0;
          const u32x4 kk = *(const u32x4*)(Kb + go), vv = *(const u32x4*)(Vb + go);
#pragma unroll
          for (int e = 0; e < 8; ++e) { const unsigned kw = kk[e >> 1], vw = vv[e >> 1]; const unsigned short ks = (e & 1) ? (unsigned short)(kw >> 16) : (unsigned short)(kw & 0xffffu);
              const float vf = (e & 1) ? bfhi(vw) : bflo(vw);
              KT[(d0 + e) * 136 + m] = ks; VTf[(d0 + e) * 136 + m] = f2bf(vf * zf); VTb[(d0 + e) * 136 + m] = f2bf(vf * zb); } } }
    __syncthreads();
    f32x4 af[8], ab[8];
#pragma unroll
    for (int n = 0; n < 8; ++n) { af[n] = (f32x4){0.f, 0.f, 0.f, 0.f}; ab[n] = (f32x4){0.f, 0.f, 0.f, 0.f}; }
#pragma unroll
    for (int s = 0; s < 4; ++s) {
        const bf16x8 xf = *(const LAS bf16x8*)(VTf + (16 * wv + r) * 136 + 32 * s + 8 * q), xb = *(const LAS bf16x8*)(VTb + (16 * wv + r) * 136 + 32 * s + 8 * q);
#pragma unroll
        for (int n = 0; n < 8; ++n) { const bf16x8 y = *(const LAS bf16x8*)(KT + (16 * n + r) * 136 + 32 * s + 8 * q); af[n] = mma(y, xf, af[n]); ab[n] = mma(y, xb, ab[n]); }
    }
    float* kvf = (float*)(P.ws + WS_KV) + ((size_t)(bh * 34 + chunk) * 2) * 16384 + (size_t)(16 * wv + r) * 128 + 4 * q; float* kvb = kvf + 16384;
#pragma unroll
    for (int n = 0; n < 8; ++n) { *(f32x4*)(kvf + 16 * n) = af[n]; *(f32x4*)(kvb + 16 * n) = ab[n]; }
    __syncthreads();
}
DI void conv_unit(const Params& P, ldsp lds, int j, int ct) {
    const int tid = opaque_tid(), lane = tid & 63, wv = tid >> 6;
    const bf16_t* U = (const bf16_t*)(P.ws + WS_P + 4 * SZ_HALF); bf16_t* MIX = (bf16_t*)(P.ws + WS_MIX);
    const int row0 = ct * 32; int s0, len; if (row0 < NLAT) { s0 = row0 & ~4095; len = 4096; } else { s0 = NLAT + ((row0 - NLAT) & ~255); len = 256; }
    LAS unsigned* uw = (LAS unsigned*)lds;
    LAS float* wl = (LAS float*)(lds + 62 * 1024);
    LAS float* cb = (LAS float*)lds;
#pragma unroll
    for (int it = 0; it < 8; ++it) { const int idx = tid + 512 * it; if (idx < 62 * 64) { const int rr = row0 - 15 + (idx >> 6), ch = idx & 63;
        u32x4 v = (u32x4){0u, 0u, 0u, 0u}; if (rr >= s0 && rr < s0 + len) v = *(const u32x4*)(U + (size_t)rr * 512 + ch * 8);
        *(LAS u32x4*)(uw + (idx >> 6) * 256 + ch * 4) = v;
        *(LAS f32x4*)(wl + idx * 4) = *(const f32x4*)(P.conv_w + (size_t)j * 31 * 512 + idx * 4); } }
    __syncthreads();
    const int cp = tid & 255, half = tid >> 8;
    float a0[16], a1[16];
    { unsigned win[46];
#pragma unroll
      for (int i = 0; i < 46; ++i) win[i] = uw[(16 * half + i) * 256 + cp];
#pragma unroll
      for (int t = 0; t < 16; ++t) { a0[t] = 0.f; a1[t] = 0.f; }
#pragma unroll
      for (int k = 0; k < 31; ++k) { const f32x2 w = *(const LAS f32x2*)(wl + k * 512 + 2 * cp);
#pragma unroll
          for (int t = 0; t < 16; ++t) { a0[t] += w.x * bflo(win[t + k]); a1[t] += w.y * bfhi(win[t + k]); } } }
    __syncthreads();
#pragma unroll
    for (int t = 0; t < 16; ++t) *(LAS f32x2*)(cb + (16 * half + t) * 516 + 2 * cp) = (f32x2){a0[t], a1[t]};
    __syncthreads();
    { const f32x4 lw0 = *(const f32x4*)(P.conv_ln_w + j * 512 + 8 * lane), lw1 = *(const f32x4*)(P.conv_ln_w + j * 512 + 8 * lane + 4);
      const f32x4 lb0 = *(const f32x4*)(P.conv_ln_b + j * 512 + 8 * lane), lb1 = *(const f32x4*)(P.conv_ln_b + j * 512 + 8 * lane + 4);
#pragma unroll
      for (int tt = 0; tt < 4; ++tt) { const int tok = 4 * wv + tt;
          f32x4 v0 = *(const LAS f32x4*)(cb + tok * 516 + 8 * lane), v1 = *(const LAS f32x4*)(cb + tok * 516 + 8 * lane + 4);
          const float mean = wave_sum(v0[0] + v0[1] + v0[2] + v0[3] + v1[0] + v1[1] + v1[2] + v1[3]) * (1.0f / 512.0f);
          v0 = v0 - mean; v1 = v1 - mean;
          const float var = wave_sum(v0[0] * v0[0] + v0[1] * v0[1] + v0[2] * v0[2] + v0[3] * v0[3] + v1[0] * v1[0] + v1[1] * v1[1] + v1[2] * v1[2] + v1[3] * v1[3]) * (1.0f / 512.0f);
          const float rstd = rsqrtf(var + EPS);
          v0 = v0 * rstd * lw0 + lb0; v1 = v1 * rstd * lw1 + lb1;
          u32x4 o; o.x = pack2(silu_f(v0[0]), silu_f(v0[1])); o.y = pack2(silu_f(v0[2]), silu_f(v0[3])); o.z = pack2(silu_f(v1[0]), silu_f(v1[1])); o.w = pack2(silu_f(v1[2]), silu_f(v1[3]));
          *(u32x4*)(MIX + (size_t)(row0 + tok) * D + 512 + 8 * lane) = o; } }
    __syncthreads();
}
DI void ph_ret_kv_conv(const Params& P, ldsp lds, int j, int n_conv_tiles) {
    const int G = gridDim.x;
    for (int u = blockIdx.x; u < 544; u += G) ret_kv_unit(P, lds, j, u);
    for (int u = G - 1 - (int)blockIdx.x; u < n_conv_tiles; u += G) conv_unit(P, lds, j, u);
}
DI void ph_scan(const Params& P, int j) {
    f32x4* kv = (f32x4*)(P.ws + WS_KV);
    for (int idx = blockIdx.x * 512 + opaque_tid(); idx < 16 * 2 * 4096; idx += gridDim.x * 512) {
        const int bh = idx >> 13, dir = (idx >> 12) & 1, e4 = idx & 4095, h = bh & 3;
        const float dec = exp2f(128.0f * log2_decay(P.ret_decay + j * 8 + dir * 4 + h));
        f32x4 carry = (f32x4){0.f, 0.f, 0.f, 0.f};
#pragma unroll 1
        for (int k0 = 0; k0 < 34; k0 += 17) { f32x4 v[17]; f32x4* ptr[17];
#pragma unroll
            for (int i = 0; i < 17; ++i) { const int k = k0 + i, c = dir == 0 ? k : (k < 2 ? 1 - k : 35 - k); ptr[i] = kv + ((size_t)(bh * 34 + c) * 2 + dir) * 4096 + e4; v[i] = *ptr[i]; }
#pragma unroll
            for (int i = 0; i < 17; ++i) { *ptr[i] = carry; carry = carry * dec + v[i]; } }
    }
}
DI void ret_out_unit(const Params& P, ldsp lds, int j, int bh, int chunk) {
    const int tid = opaque_tid(), lane = tid & 63, wv = tid >> 6, r = lane & 15, q = lane >> 4;
    const int b = bh >> 2, h = bh & 3, row0 = chunk_row0(b, chunk);
    const float l2f = log2_decay(P.ret_decay + j * 8 + h), l2b = log2_decay(P.ret_decay + j * 8 + 4 + h);
    const bf16_t* Qb = (const bf16_t*)(P.ws + WS_P); const bf16_t* Kb = (const bf16_t*)(P.ws + WS_P + SZ_HALF); const bf16_t* Vb = (const bf16_t*)(P.ws + WS_P + 2 * SZ_HALF);
    const bf16_t* Gb = (const bf16_t*)(P.ws + WS_P + 3 * SZ_HALF); bf16_t* MIX = (bf16_t*)(P.ws + WS_MIX);
    LAS unsigned short* Ks = (LAS unsigned short*)lds; LAS unsigned short* VT = Ks + 128 * 136; LAS unsigned short* SfT = VT + 128 * 136; LAS unsigned short* SbT = SfT + 128 * 136;
#pragma unroll
    for (int it = 0; it < 4; ++it) { const int idx = tid + 512 * it, jj = idx >> 4, ch = idx & 15;
        *(LAS u32x4*)(Ks + jj * 136 + ch * 8) = *(const u32x4*)(Kb + (size_t)(row0 + jj) * 512 + h * 128 + ch * 8); }
    { const int m = tid & 127, dq = tid >> 7;
#pragma unroll
      for (int c4 = 0; c4 < 4; ++c4) { const int d0 = (dq * 4 + c4) * 8; const u32x4 vv = *(const u32x4*)(Vb + (size_t)(row0 + m) * 512 + h * 128 + d0);
#pragma unroll
          for (int e = 0; e < 8; ++e) { const unsigned vw = vv[e >> 1]; VT[(d0 + e) * 136 + m] = (e & 1) ? (unsigned short)(vw >> 16) : (unsigned short)(vw & 0xffffu); } } }
    { const float* sf = (const float*)(P.ws + WS_KV) + ((size_t)(bh * 34 + chunk) * 2) * 16384; const float* sb = sf + 16384;
#pragma unroll
      for (int it = 0; it < 8; ++it) { const int idx = tid + 512 * it, e = idx >> 5, c4 = idx & 31;
          const f32x4 a = *(const f32x4*)(sf + e * 128 + 4 * c4), bb = *(const f32x4*)(sb + e * 128 + 4 * c4);
          u32x2 wa, wb; wa.x = pack2(a[0], a[1]); wa.y = pack2(a[2], a[3]); wb.x = pack2(bb[0], bb[1]); wb.y = pack2(bb[2], bb[3]);
          *(LAS u32x2*)(SfT + e * 136 + 4 * c4) = wa; *(LAS u32x2*)(SbT + e * 136 + 4 * c4) = wb; } }
    const int i = 16 * wv + r; const size_t grow = (size_t)(row0 + i);
    bf16x8 xq[4];
#pragma unroll
    for (int s = 0; s < 4; ++s) xq[s] = *(const bf16x8*)(Qb + grow * 512 + h * 128 + 32 * s + 8 * q);
    __syncthreads();
    f32x4 sc[8];
#pragma unroll
    for (int jt = 0; jt < 8; ++jt) { sc[jt] = (f32x4){0.f, 0.f, 0.f, 0.f};
#pragma unroll
        for (int s = 0; s < 4; ++s) { const bf16x8 y = *(const LAS bf16x8*)(Ks + (16 * jt + r) * 136 + 32 * s + 8 * q); sc[jt] = mma(y, xq[s], sc[jt]); } }
    bf16x8 xp[4];
#pragma unroll
    for (int s = 0; s < 4; ++s) { u32x4 w;
#pragma unroll
        for (int half = 0; half < 2; ++half) { const int jt = 2 * s + half; float p[4];
#pragma unroll
            for (int t = 0; t < 4; ++t) { const int dl = i - (16 * jt + 4 * q + t); const float f = dl >= 0 ? exp2f(l2f * (float)dl) : exp2f(l2b * (float)(-dl - 1)); p[t] = sc[jt][t] * f; }
            w[2 * half] = pack2(p[0], p[1]); w[2 * half + 1] = pack2(p[2], p[3]); }
        xp[s] = __builtin_bit_cast(bf16x8, w); }
    const float xif = exp2f(l2f * (float)(i + 1)), xib = exp2f(l2b * (float)(127 - i));
    f32x4 o[8]; float ss = 0.f;
#pragma unroll
    for (int et = 0; et < 8; ++et) { f32x4 a = (f32x4){0.f, 0.f, 0.f, 0.f}, tf = a, tb = a;
#pragma unroll
        for (int s = 0; s < 4; ++s) { const LAS unsigned short* vp = VT + (16 * et + r) * 136 + 32 * s + 4 * q;
            const u32x2 y0 = *(const LAS u32x2*)vp, y1 = *(const LAS u32x2*)(vp + 16); const u32x4 yw = (u32x4){y0.x, y0.y, y1.x, y1.y};
            a = mma(__builtin_bit_cast(bf16x8, yw), xp[s], a);
            tf = mma(*(const LAS bf16x8*)(SfT + (16 * et + r) * 136 + 32 * s + 8 * q), xq[s], tf);
            tb = mma(*(const LAS bf16x8*)(SbT + (16 * et + r) * 136 + 32 * s + 8 * q), xq[s], tb); }
        a = a + tf * xif + tb * xib; o[et] = a; ss += a[0] * a[0] + a[1] * a[1] + a[2] * a[2] + a[3] * a[3]; }
    ss += __shfl_xor(ss, 16); ss += __shfl_xor(ss, 32);
    const float rinv = rsqrtf(ss * (1.0f / 128.0f) + EPS);
#pragma unroll
    for (int et = 0; et < 8; ++et) { const u32x2 gw = *(const u32x2*)(Gb + grow * 512 + h * 128 + 16 * et + 4 * q);
        u32x2 w; w.x = pack2(silu_f(bflo(gw.x)) * o[et][0] * rinv, silu_f(bfhi(gw.x)) * o[et][1] * rinv); w.y = pack2(silu_f(bflo(gw.y)) * o[et][2] * rinv, silu_f(bfhi(gw.y)) * o[et][3] * rinv);
        *(u32x2*)(MIX + grow * D + h * 128 + 16 * et + 4 * q) = w; }
    __syncthreads();
}
DI void ph_ret_out(const Params& P, ldsp lds, int j, bool with_ctx) {
    const int nper = with_ctx ? 34 : 32, n = 16 * nper;
    for (int u = blockIdx.x; u < n; u += gridDim.x) { const int bh = u / nper, chunk = u % nper + (with_ctx ? 0 : 2); ret_out_unit(P, lds, j, bh, chunk); }
}

DI void sg_unit(const Params& P, ldsp lds, int j, int chunk, int g) {
    const int tid = opaque_tid(), lane = tid & 63, wv = tid >> 6, r = lane & 15, q = lane >> 4, row0 = chunk * 128;
    const bf16_t* Z = (const bf16_t*)(P.ws + WS_P + SZ_HALF); bf16_t* MIX = (bf16_t*)(P.ws + WS_MIX);
    LAS f32x2* st = (LAS f32x2*)lds; LAS unsigned short* VnT = (LAS unsigned short*)(lds + 1024);
#pragma unroll 4
    for (int t = 0; t < 16; ++t) { const int p = 16 * wv + t; const u32x4 w = *(const u32x4*)(Z + (size_t)(row0 + p) * 1024 + 512 + 8 * lane);
        float f[8]; f[0] = bflo(w.x); f[1] = bfhi(w.x); f[2] = bflo(w.y); f[3] = bfhi(w.y); f[4] = bflo(w.z); f[5] = bfhi(w.z); f[6] = bflo(w.w); f[7] = bfhi(w.w);
        const float mean = wave_sum(f[0] + f[1] + f[2] + f[3] + f[4] + f[5] + f[6] + f[7]) * (1.0f / 512.0f); float vs = 0.f;
#pragma unroll
        for (int e = 0; e < 8; ++e) { const float dlt = f[e] - mean; vs += dlt * dlt; }
        const float var = wave_sum(vs) * (1.0f / 512.0f); if (lane == 0) st[p] = (f32x2){mean, rsqrtf(var + EPS)}; }
    __syncthreads();
    { const int p = tid & 127, cq = tid >> 7; const f32x2 s = st[p];
#pragma unroll
      for (int c4 = 0; c4 < 4; ++c4) { const int c0 = (cq * 4 + c4) * 8, ch = g * 128 + c0; const u32x4 w = *(const u32x4*)(Z + (size_t)(row0 + p) * 1024 + 512 + ch);
          const float* lw = P.sg_ln_w + j * 512 + ch; const float* lb = P.sg_ln_b + j * 512 + ch;
#pragma unroll
          for (int e = 0; e < 8; ++e) { const unsigned ww = w[e >> 1]; const float vf = (e & 1) ? bfhi(ww) : bflo(ww); VnT[(c0 + e) * 136 + p] = f2bf((vf - s.x) * s.y * lw[e] + lb[e]); } } }
    const bf16_t* W = (const bf16_t*)(P.ws + WS_SGW) + (size_t)(j * 4 + g) * 16384; const int qq = 16 * wv + r;
    bf16x8 xw[4];
#pragma unroll
    for (int s = 0; s < 4; ++s) xw[s] = *(const bf16x8*)(W + qq * 128 + 32 * s + 8 * q);
    __syncthreads();
    const float bias = P.sg_b[(j * 4 + g) * 128 + qq];
#pragma unroll
    for (int ct = 0; ct < 8; ++ct) { f32x4 a = (f32x4){0.f, 0.f, 0.f, 0.f};
#pragma unroll
        for (int s = 0; s < 4; ++s) a = mma(*(const LAS bf16x8*)(VnT + (16 * ct + r) * 136 + 32 * s + 8 * q), xw[s], a);
        const size_t go = (size_t)(row0 + qq) * 1024 + g * 128 + 16 * ct + 4 * q; const u32x2 uw = *(const u32x2*)(Z + go);
        u32x2 w; w.x = pack2(bflo(uw.x) * (a[0] + bias), bfhi(uw.x) * (a[1] + bias)); w.y = pack2(bflo(uw.y) * (a[2] + bias), bfhi(uw.y) * (a[3] + bias));
        *(u32x2*)(MIX + go + 512) = w; }
    __syncthreads();
}
DI void pool_unit(const Params& P, int j, int chunk, int g) {
    const int tid = opaque_tid(), lane = tid & 63, wv = tid >> 6, r = lane & 15, q = lane >> 4, row0 = chunk * 128;
    const bf16_t* PC = (const bf16_t*)(P.ws + WS_P); bf16_t* MIX = (bf16_t*)(P.ws + WS_MIX);
    int s0, len; if (row0 < NLAT) { s0 = row0 & ~4095; len = 4096; } else { s0 = NLAT + ((row0 - NLAT) & ~255); len = 256; }
    const int w = 2 << g, left = w >> 1, right = w - 1 - left, row = row0 + 16 * wv + r;
    int lo = row - left, hi = row + right; if (lo < s0) lo = s0; if (hi > s0 + len - 1) hi = s0 + len - 1;
    const float inv = 1.0f / (float)(hi - lo + 1);
    bf16x8 xm[4];
#pragma unroll
    for (int s = 0; s < 4; ++s) { const int co = g * 128 + 32 * s + 8 * q; float acc[8];
#pragma unroll
        for (int e = 0; e < 8; ++e) acc[e] = 0.f;
        for (int rr = lo; rr <= hi; ++rr) { const u32x4 v = *(const u32x4*)(PC + (size_t)rr * 512 + co);
            acc[0] += bflo(v.x); acc[1] += bfhi(v.x); acc[2] += bflo(v.y); acc[3] += bfhi(v.y); acc[4] += bflo(v.z); acc[5] += bfhi(v.z); acc[6] += bflo(v.w); acc[7] += bfhi(v.w); }
        const u32x4 t = *(const u32x4*)(PC + (size_t)row * 512 + co); u32x4 o;
        o.x = pack2(acc[0] * inv - bflo(t.x), acc[1] * inv - bfhi(t.x)); o.y = pack2(acc[2] * inv - bflo(t.y), acc[3] * inv - bfhi(t.y));
        o.z = pack2(acc[4] * inv - bflo(t.z), acc[5] * inv - bfhi(t.z)); o.w = pack2(acc[6] * inv - bflo(t.w), acc[7] * inv - bfhi(t.w));
        xm[s] = __builtin_bit_cast(bf16x8, o); }
    const bf16_t* W = (const bf16_t*)(P.ws + WS_PWT) + (size_t)(j * 4 + g) * 16384;
#pragma unroll
    for (int dt = 0; dt < 8; ++dt) { f32x4 a = (f32x4){0.f, 0.f, 0.f, 0.f};
#pragma unroll
        for (int s = 0; s < 4; ++s) a = mma(*(const bf16x8*)(W + (16 * dt + r) * 128 + 32 * s + 8 * q), xm[s], a);
        const int dc = g * 128 + 16 * dt + 4 * q; const f32x4 ps = *(const f32x4*)(P.pool_scale + j * 512 + dc);
        u32x2 o; o.x = pack2(a[0] * ps[0], a[1] * ps[1]); o.y = pack2(a[2] * ps[2], a[3] * ps[3]);
        *(u32x2*)(MIX + (size_t)row * D + dc) = o; }
}
DI void ph_oddmix(const Params& P, ldsp lds, int j, int nchunks) {
    const int G = gridDim.x, n = nchunks * 4;
    for (int u = blockIdx.x; u < n; u += G) sg_unit(P, lds, j, u >> 2, u & 3);
    for (int u = G - 1 - (int)blockIdx.x; u < n; u += G) pool_unit(P, j, u >> 2, u & 3);
}
DI void ph_final(const Params& P) {
    const int tid = opaque_tid(), lane = tid & 63, wv = tid >> 6; const float* xr = (const float*)(P.ws + WS_XR);
    for (int row = blockIdx.x * 8 + wv; row < NLAT; row += gridDim.x * 8) {
        const f32x4* xp = (const f32x4*)(xr + (size_t)row * D); f32x4 v[4]; float ss = 0.f;
#pragma unroll
        for (int j = 0; j < 4; ++j) { v[j] = xp[j * 64 + lane]; ss += v[j][0] * v[j][0] + v[j][1] * v[j][1] + v[j][2] * v[j][2] + v[j][3] * v[j][3]; }
        ss = wave_sum(ss); const float rstd = rsqrtf(ss * (1.0f / 1024.0f) + EPS);
#pragma unroll
        for (int j = 0; j < 4; ++j) { const int c = (j * 64 + lane) * 4; *(f32x4*)(P.out + (size_t)row * D + c) = v[j] * rstd * *(const f32x4*)(P.final_w + c); }
    }
}

__global__ void __launch_bounds__(512) mega(Params P) {
    extern __shared__ __attribute__((aligned(16))) unsigned char smem[];
    ldsp lds = (ldsp)smem;
    cg::grid_group grid = cg::this_grid();
    unsigned char* ws = P.ws; unsigned char* wb = ws + WS_WB;
    bf16_t* H = (bf16_t*)(ws + WS_H); bf16_t* MIX = (bf16_t*)(ws + WS_MIX); bf16_t* ACT = (bf16_t*)(ws + WS_P); float* XR = (float*)(ws + WS_XR);
    const float* mod = (const float*)(ws + WS_MOD);
    ph_init(P, lds); grid.sync();
#pragma unroll 1
    for (int i = 0; i < 4; ++i) {
        const int j = i >> 1; const bool even = !(i & 1);
        const int M1 = i <= 2 ? MTOT : NLAT, M2 = i <= 1 ? MTOT : NLAT;
        ph_norm(P, lds, i, 0, M1, true); grid.sync();
        if (even) {
            EpiEvenIn E{(bf16_t*)(ws + WS_P), (bf16_t*)(ws + WS_P + SZ_HALF), (bf16_t*)(ws + WS_P + 2 * SZ_HALF), (bf16_t*)(ws + WS_P + 3 * SZ_HALF), (bf16_t*)(ws + WS_P + 4 * SZ_HALF), (const float*)(ws + WS_ROPE)};
            run_gemm(lds, H, (const bf16_t*)(wb + WB_IN), M1, 3072, 1024, E); grid.sync();
            ph_ret_kv_conv(P, lds, j, M2 / 32); grid.sync();
            ph_scan(P, j); grid.sync();
            ph_ret_out(P, lds, j, M2 == MTOT); grid.sync();
        } else {
            EpiOddIn E{(bf16_t*)(ws + WS_P), (bf16_t*)(ws + WS_P + SZ_HALF)};
            run_gemm(lds, H, (const bf16_t*)(wb + WB_IN), M1, 1536, 1024, E); grid.sync();
            ph_oddmix(P, lds, j, M2 / 128); grid.sync();
        }
        { EpiRes E{XR, mod + (size_t)i * 5 * 6144 + 2 * 1024}; run_gemm(lds, MIX, (const bf16_t*)(wb + WB_OUT), M2, 1024, 1024, E); } grid.sync();
        ph_norm(P, lds, i, 1, M2, false); grid.sync();
        { EpiGU E{ACT}; run_gemm(lds, H, (const bf16_t*)(wb + WB_GU), M2, 5632, 1024, E); } grid.sync();
        { EpiRes E{XR, mod + (size_t)i * 5 * 6144 + 5 * 1024}; run_gemm(lds, ACT, (const bf16_t*)(wb + WB_DN), M2, 1024, 2816, E); } grid.sync();
    }
    ph_final(P);
}
}

extern "C" void kernel_launch(void* const* d_in, const int* in_sizes, int n_in, void* d_out, int out_size, void* d_ws, size_t ws_size, hipStream_t stream) {
    static int grid = 0;
    if (grid == 0) {
        if (n_in != 25 || ws_size < mk::WS_END) { fprintf(stderr, "kernel_launch: need 25 inputs and %zu bytes of workspace (got %d, %zu)\n", (size_t)mk::WS_END, n_in, ws_size); grid = -1; return; }
        int dev = 0, cus = 0, per_cu = 0;
        hipGetDevice(&dev); hipDeviceGetAttribute(&cus, hipDeviceAttributeMultiprocessorCount, dev);
        if (hipFuncSetAttribute((const void*)mk::mega, hipFuncAttributeMaxDynamicSharedMemorySize, mk::LDS_BYTES) != hipSuccess) { fprintf(stderr, "kernel_launch: hipFuncSetAttribute failed\n"); grid = -1; return; }
        if (hipOccupancyMaxActiveBlocksPerMultiprocessor(&per_cu, (const void*)mk::mega, 512, mk::LDS_BYTES) != hipSuccess || per_cu < 1) { fprintf(stderr, "kernel_launch: occupancy query failed (%d)\n", per_cu); grid = -1; return; }
        grid = cus * (per_cu > 1 ? 1 : per_cu);
    }
    if (grid < 0) return;
    mk::Params p{};
    const float** pp = (const float**)&p;
    for (int i = 0; i < 25; ++i) pp[i] = (const float*)d_in[i];
    p.out = (float*)d_out; p.ws = (unsigned char*)d_ws;
    void* args[] = {&p};
    hipError_t e = hipLaunchCooperativeKernel((const void*)mk::mega, dim3(grid), dim3(512), args, mk::LDS_BYTES, stream);
    if (e != hipSuccess) fprintf(stderr, "cooperative launch failed: %s (grid %d)\n", hipGetErrorString(e), grid);
}
```

```cpp
#include <hip/hip_runtime.h>
#include <hip/hip_cooperative_groups.h>
#include <cstdio>
namespace cg = cooperative_groups;
#define LAS __attribute__((address_space(3)))
#define XB_TMO      128
#define XB_XCNT(j)  (256  + 64 * (j))
#define XB_XSUB(j)  (1280 + 64 * (j))
#define XB_XGEN(j)  (2304 + 64 * (j))
#define XB_TOP      3328
#define XB_TOPGEN   3392
#define XCD_BAR_WORDS 3456
#define XB_SPIN_CAP (1u << 18)

__device__ __forceinline__ unsigned xb_ld(unsigned* p)              { return __hip_atomic_load(p, __ATOMIC_RELAXED, __HIP_MEMORY_SCOPE_AGENT); }
__device__ __forceinline__ unsigned xb_add(unsigned* p, unsigned v) { return __hip_atomic_fetch_add(p, v, __ATOMIC_RELAXED, __HIP_MEMORY_SCOPE_AGENT); }
__device__ __forceinline__ unsigned xb_xcc_id() { return (unsigned)__builtin_amdgcn_s_getreg((3 << 11) | 20) & 0xFu; }
#define XB_SPIN(cond, bar) do { unsigned _sp = 0; while (cond) { __builtin_amdgcn_s_sleep(1); \
    if ((++_sp & 255u) == 0u) { if (xb_ld(&(bar)[XB_TMO])) break; if (_sp > XB_SPIN_CAP) { atomicAdd(&(bar)[XB_TMO], 1u); break; } } } } while (0)

struct XcdBarrier {
    unsigned* bar; unsigned x;
    volatile LAS unsigned* st;
};

__device__ __forceinline__ XcdBarrier xcd_barrier_post(unsigned* bar, volatile LAS unsigned* st) {
    XcdBarrier b; b.bar = bar; b.x = xb_xcc_id(); b.st = st;
    if (threadIdx.x == 0) (void)xb_add(&bar[XB_XCNT(b.x)], 1u);
    return b;
}
__device__ __forceinline__ void xcd_barrier_complete(unsigned* bar, unsigned x, unsigned& nloc, unsigned& nx) {
    const unsigned G = gridDim.x * gridDim.y * gridDim.z;
    unsigned sum, cnt, mine, sp = 0u;
    for (;;) {
        sum = 0u; cnt = 0u; mine = 0u;
#pragma unroll
        for (unsigned j = 0; j < 16; ++j) { const unsigned c = xb_ld(&bar[XB_XCNT(j)]); sum += c; cnt += (c > 0u) ? 1u : 0u; mine = (j == x) ? c : mine; }
        if (sum == G) break;
        __builtin_amdgcn_s_sleep(1);
        if ((++sp & 255u) == 0u) { if (xb_ld(&bar[XB_TMO])) break; if (sp > XB_SPIN_CAP) { atomicAdd(&bar[XB_TMO], 1u); break; } }
    }
    nloc = mine > 0u ? mine : 1u; nx = cnt > 0u ? cnt : 1u;
}

__device__ __forceinline__ void xcd_barrier(const XcdBarrier& b) {
    asm volatile("s_waitcnt vmcnt(0)" ::: "memory");
    __syncthreads();
    if (threadIdx.x == 0) {
        unsigned* bar = b.bar;
        __builtin_amdgcn_s_waitcnt(0);
        unsigned nloc = b.st[0], nx = b.st[1];
        if (nloc == 0u) { xcd_barrier_complete(bar, b.x, nloc, nx); b.st[0] = nloc; b.st[1] = nx; }
        const unsigned old = xb_add(&bar[XB_XSUB(b.x)], 1u);
        const unsigned gen = old / nloc;
        if (old + 1u == (gen + 1u) * nloc) {
            __builtin_amdgcn_fence(__ATOMIC_RELEASE, "agent");
            asm volatile("s_waitcnt vmcnt(0)" ::: "memory");
            const unsigned og = xb_add(&bar[XB_TOP], 1u);
            const unsigned tg = og / nx;
            if (og + 1u == (tg + 1u) * nx) xb_add(&bar[XB_TOPGEN], 1u);
            else XB_SPIN(xb_ld(&bar[XB_TOPGEN]) == tg, bar);
            __builtin_amdgcn_fence(__ATOMIC_ACQUIRE, "agent");
            xb_add(&bar[XB_XGEN(b.x)], 1u);
            asm volatile("s_waitcnt vmcnt(0)" ::: "memory");
        } else {
            XB_SPIN(xb_ld(&bar[XB_XGEN(b.x)]) == gen, bar);
            __builtin_amdgcn_fence(__ATOMIC_ACQUIRE, "agent");
            asm volatile("s_waitcnt vmcnt(0)" ::: "memory");
        }
    }
    __syncthreads();
}
namespace pg8 {
#define PG8_LAS __attribute__((address_space(3)))
typedef unsigned short bf16_t;
typedef short bf16x8 __attribute__((ext_vector_type(8)));
typedef float f32x4 __attribute__((ext_vector_type(4)));
typedef unsigned u32x4 __attribute__((ext_vector_type(4)));
constexpr int BM = 256, BK = 64, HALF = 128, HTB = HALF * BK * 2  , STAGE_BYTES = 8 * HTB, NXCD = 8, WGM = 8;

__host__ __device__ __forceinline__ int lds_byte(int r, int c) { const int st = (r >> 4) * 2 + (c >> 5), rr = r & 15, cc = c & 31, ob = rr * 64 + cc * 2; return st * 1024 + (ob ^ (((ob >> 9) & 1) << 5)); }
__host__ __device__ __forceinline__ void stage_rc(int b, int& R, int& C) { const int st = b / 1024, sb = b % 1024, swz = sb ^ (((sb >> 9) & 1) << 5); R = (st >> 1) * 16 + swz / 64; C = (st & 1) * 32 + (swz % 64) / 2; }
__host__ __device__ __forceinline__ int perm32(int rho) { const int n = rho >> 4, i = rho & 15; return 8 * (i >> 2) + 4 * n + (i & 3); }

struct Unit { int pm, pn; };
struct Gemm { const bf16_t* A; const bf16_t* Bt; int M, N, K; };

struct StaticOrder {
    int nM, nN, nwg, G, c;
    __host__ __device__ void init(int M, int N, int G_, int c_) { nM = M / BM; nN = N / BM; nwg = nM * nN; G = G_; c = c_; }
    __host__ __device__ bool next(int i, Unit& u) const {
        const long L = (long)i * G + c; if (L >= nwg) return false;
        int wgid = (int)L; { const int q = nwg / NXCD, r = nwg % NXCD, xcd = wgid % NXCD, off = wgid / NXCD; wgid = (xcd < r ? xcd * (q + 1) : r * (q + 1) + (xcd - r) * q) + off; }
        const int nig = WGM * nN, gid = wgid / nig, fm = gid * WGM, gsz = (nM - fm) < WGM ? (nM - fm) : WGM;
        u.pm = fm + ((wgid % nig) % gsz); u.pn = (wgid % nig) / gsz; return true;
    }
    __device__ __forceinline__ void a_ready(const Unit&) const {}
    __device__ __forceinline__ void done(const Unit&) const {}
};
__device__ __forceinline__ unsigned cvt_pk_bf16(float lo, float hi) { unsigned r; asm volatile("v_cvt_pk_bf16_f32 %0, %1, %2" : "=v"(r) : "v"(lo), "v"(hi)); return r; }
typedef float f32x2 __attribute__((ext_vector_type(2)));
__device__ __forceinline__ f32x2 gelu_pk(f32x2 v) {
    const f32x2 av = __builtin_elementwise_abs(v), d = av * 0.2316418882f + 1.0f;
    f32x2 t; t.x = __builtin_amdgcn_rcpf(d.x); t.y = __builtin_amdgcn_rcpf(d.y);
    f32x2 q = t * 0.5307027145f + (-0.7265760135f); q = q * t + 0.7107068705f; q = q * t + (-0.142248368f); q = q * t + 0.127414796f; q = q * t;
    const f32x2 s = (v * v) * (-0.72134752044f);
    f32x2 e; e.x = __builtin_amdgcn_exp2f(s.x); e.y = __builtin_amdgcn_exp2f(s.y);
    const f32x2 m = v * (q * e), r = v - m;
    f32x2 o; o.x = v.x < 0.f ? m.x : r.x; o.y = v.y < 0.f ? m.y : r.y; return o;
}

template <class Epi, class Sched, bool STAMP = false>
__device__ __forceinline__ void gemm_phase(PG8_LAS unsigned char* lds, const Gemm g, const Sched& S, const Epi& E, unsigned long long* stamps) {
    int tid_ = threadIdx.x; asm volatile("" : "+v"(tid_)); const int tid = tid_, wid = __builtin_amdgcn_readfirstlane(tid >> 6), lane = tid & 63, wr = wid >> 2, wc = wid & 3, fr = lane & 15, fq = lane >> 4;
    const int K = g.K, nt = K / BK;
    int ts_lo = 0, ts_hi = 0, nts = 0; const unsigned long long rt_entry = STAMP ? (unsigned long long)wall_clock64() : 0ull;
#define PG8_STAMP() do { if (STAMP && wid == 0 && nts < 64) { const unsigned long long _c = (unsigned long long)clock64(); \
        ts_lo = (lane == nts) ? (int)(unsigned)_c : ts_lo; ts_hi = (lane == nts) ? (int)(unsigned)(_c >> 32) : ts_hi; ++nts; } } while (0)
    PG8_STAMP();
    unsigned voffA[2], voffB[2];
#pragma unroll
    for (int i = 0; i < 2; ++i) { int R, C; stage_rc(tid * 16 + i * 8192, R, C); const int Rb = Epi::PERM ? ((R & ~31) + perm32(R & 31)) : R;
        voffA[i] = (unsigned)(R * K + C) * 2u; voffB[i] = (unsigned)(Rb * K + C) * 2u; }
    const size_t kstep = (size_t)(BK * 2);
    const size_t hstep = (size_t)HALF * K * 2;
    const size_t tstep = 2 * hstep;
    const unsigned ldsw = (unsigned)wid * 1024u;
    const int aoff = lds_byte(wr * 64 + fr, fq * 8), boff = lds_byte(wc * 32 + fr, fq * 8);
#define PG8_SA(b, h) (((b) * 2 + (h)) * HTB)
#define PG8_SB(b, h) ((4 + (b) * 2 + (h)) * HTB)
#define PG8_STAGE(bufoff, gbase, voff) do { _Pragma("unroll") for (int _i = 0; _i < 2; ++_i) \
        __builtin_amdgcn_global_load_lds((const unsigned*)((const char*)(gbase) + (voff)[_i]), (PG8_LAS unsigned*)(lds + (bufoff) + ldsw + _i * 8192), 16, 0, 0); } while (0)
#define PG8_LDA(dst, b, h) do { _Pragma("unroll") for (int m = 0; m < 4; ++m) _Pragma("unroll") for (int k = 0; k < 2; ++k) dst[m][k] = *(const PG8_LAS bf16x8*)(lds + PG8_SA(b, h) + aoff + m * 2048 + k * 1024); } while (0)
#define PG8_LDB(dst, b, h) do { _Pragma("unroll") for (int n = 0; n < 2; ++n) _Pragma("unroll") for (int k = 0; k < 2; ++k) dst[n][k] = *(const PG8_LAS bf16x8*)(lds + PG8_SB(b, h) + boff + n * 2048 + k * 1024); } while (0)
#define PG8_MMA(ai, bj, At, Bt) do { __builtin_amdgcn_s_setprio(1); _Pragma("unroll") for (int m = 0; m < 4; ++m) _Pragma("unroll") for (int n = 0; n < 2; ++n) _Pragma("unroll") for (int k = 0; k < 2; ++k) \
        acc[ai][bj][m][n] = __builtin_amdgcn_mfma_f32_16x16x32_bf16(Bt[n][k], At[m][k], acc[ai][bj][m][n], 0, 0, 0); __builtin_amdgcn_s_setprio(0); } while (0)
#define PG8_WAIT_V(n) asm volatile("s_waitcnt vmcnt(" #n ")" ::: "memory")
#define PG8_WAIT_L(n) asm volatile("s_waitcnt lgkmcnt(" #n ")" ::: "memory")
#define PG8_BAR __builtin_amdgcn_s_barrier()
#define PG8_SCHED __builtin_amdgcn_sched_barrier(0)
    Unit cur, nxt; int ui = 0;
    if (!S.next(0, cur)) return;
    f32x4 acc[2][2][4][2];
#pragma unroll
    for (int a = 0; a < 2; ++a)
#pragma unroll
        for (int b = 0; b < 2; ++b)
#pragma unroll
            for (int m = 0; m < 4; ++m)
#pragma unroll
                for (int n = 0; n < 2; ++n) acc[a][b][m][n] = (f32x4){0.f, 0.f, 0.f, 0.f};
    bf16x8 At[4][2], B0[2][2], B1[2][2];
    const char* cA = (const char*)g.A + (size_t)cur.pm * tstep; const char* cB = (const char*)g.Bt + (size_t)cur.pn * tstep;
    S.a_ready(cur);
    PG8_STAGE(PG8_SB(0, 0), cB, voffB); PG8_STAGE(PG8_SA(0, 0), cA, voffA); PG8_STAGE(PG8_SB(0, 1), cB + hstep, voffB); PG8_STAGE(PG8_SA(0, 1), cA + hstep, voffA);
    if (wr == 1) PG8_BAR;
    PG8_WAIT_V(4); PG8_BAR;
    PG8_STAGE(PG8_SB(1, 0), cB + kstep, voffB); PG8_STAGE(PG8_SA(1, 0), cA + kstep, voffA); PG8_STAGE(PG8_SB(1, 1), cB + hstep + kstep, voffB);
    PG8_WAIT_V(6); PG8_BAR;
    PG8_STAMP();
    for (;;) {
        const bool has_next = S.next(ui + 1, nxt);
        const char* nA = has_next ? (const char*)g.A + (size_t)nxt.pm * tstep : cA; const char* nB = has_next ? (const char*)g.Bt + (size_t)nxt.pn * tstep : cB;
        for (int t = 0; t < nt; t += 2) {
            const bool last = (t == nt - 2);
            const char* a1 = cA + (size_t)(t + 1) * kstep;
            const char* a2 = last ? nA : cA + (size_t)(t + 2) * kstep; const char* b2 = last ? nB : cB + (size_t)(t + 2) * kstep;
            const char* a3 = a2 + kstep; const char* b3 = b2 + kstep;
            if (last && has_next) S.a_ready(nxt);
            if constexpr (Epi::STAGED) { if (last) E.stage(cur, lds, wid, lane); }
            PG8_LDB(B0, 0, 0); PG8_SCHED; PG8_LDA(At, 0, 0); PG8_STAGE(PG8_SA(1, 1), a1 + hstep, voffA);
            PG8_WAIT_L(8); PG8_BAR; PG8_WAIT_L(0); PG8_MMA(0, 0, At, B0); PG8_BAR; PG8_SCHED;
            PG8_LDB(B1, 0, 1); PG8_STAGE(PG8_SB(0, 0), b2, voffB);
            PG8_BAR; PG8_WAIT_L(0); PG8_MMA(0, 1, At, B1); PG8_BAR;
            PG8_LDA(At, 0, 1); PG8_STAGE(PG8_SA(0, 0), a2, voffA);
            PG8_BAR; PG8_WAIT_L(0); PG8_MMA(1, 0, At, B0); PG8_BAR; PG8_SCHED;
            PG8_STAGE(PG8_SB(0, 1), b2 + hstep, voffB);
            PG8_WAIT_V(6); PG8_BAR; PG8_MMA(1, 1, At, B1); PG8_BAR;
            PG8_LDB(B0, 1, 0); PG8_SCHED; PG8_LDA(At, 1, 0); PG8_STAGE(PG8_SA(0, 1), a2 + hstep, voffA);
            PG8_WAIT_L(8); PG8_BAR; PG8_WAIT_L(0); PG8_MMA(0, 0, At, B0); PG8_BAR; PG8_SCHED;
            PG8_LDB(B1, 1, 1); PG8_STAGE(PG8_SB(1, 0), b3, voffB);
            PG8_BAR; PG8_WAIT_L(0); PG8_MMA(0, 1, At, B1); PG8_BAR;
            PG8_LDA(At, 1, 1); PG8_STAGE(PG8_SA(1, 0), a3, voffA);
            PG8_BAR; PG8_WAIT_L(0); PG8_MMA(1, 0, At, B0); PG8_BAR; PG8_SCHED;
            PG8_STAGE(PG8_SB(1, 1), b3 + hstep, voffB);
            PG8_WAIT_V(6); PG8_BAR; PG8_MMA(1, 1, At, B1); PG8_BAR;
        }
        PG8_STAMP();
        if constexpr (!Epi::AFTER_DRAIN) { E(acc, cur, wr, wc, fr, fq); S.done(cur); }
        PG8_STAMP();
        if (!has_next) break;
#pragma unroll
        for (int a = 0; a < 2; ++a)
#pragma unroll
            for (int b = 0; b < 2; ++b)
#pragma unroll
                for (int m = 0; m < 4; ++m)
#pragma unroll
                    for (int n = 0; n < 2; ++n) acc[a][b][m][n] = (f32x4){0.f, 0.f, 0.f, 0.f};
        cur = nxt; cA = nA; cB = nB; ++ui;
    }
    PG8_WAIT_V(0);
    if (wr == 0) PG8_BAR;
    PG8_BAR;
    if constexpr (Epi::AFTER_DRAIN) { E.fused(acc, cur, wr, wc, fr, fq, lds, wid, lane); S.done(cur); }
    PG8_STAMP();
    if (STAMP && wid == 0) { stamps[lane] = lane < nts ? (((unsigned long long)(unsigned)ts_hi << 32) | (unsigned)ts_lo) : 0ull;
        if (lane == 62) stamps[62] = rt_entry; if (lane == 63) stamps[63] = (unsigned long long)wall_clock64(); }
#undef PG8_STAMP
#undef PG8_SA
#undef PG8_SB
#undef PG8_STAGE
#undef PG8_LDA
#undef PG8_LDB
#undef PG8_MMA
#undef PG8_WAIT_V
#undef PG8_WAIT_L
#undef PG8_BAR
#undef PG8_SCHED
}
}

namespace mk {
using pg8::bf16_t; using pg8::bf16x8; using pg8::f32x4; using pg8::u32x4; using pg8::f32x2; using pg8::Unit;
#define DI __device__ __forceinline__
typedef LAS unsigned char* ldsp;
typedef unsigned u32x2 __attribute__((ext_vector_type(2)));

constexpr int D = 1024, NLAT = 16384, MTOT = 17408, DFF = 2816;
constexpr float EPS = 1e-6f;
constexpr float LOG2E = 1.4426950408889634f;

constexpr size_t SZ_HALF = (size_t)MTOT * 512 * 2;
constexpr size_t WS_XR = 0;
constexpr size_t WS_H = WS_XR + (size_t)MTOT * D * 4;
constexpr size_t WS_P = WS_H + (size_t)MTOT * D * 2;
constexpr size_t WS_MIX = WS_P + 5 * SZ_HALF;
constexpr size_t WS_KV = WS_MIX + (size_t)MTOT * D * 2;
constexpr size_t WS_WB = WS_KV + (size_t)16 * 34 * 2 * 16384 * 4;
constexpr size_t WB_IN = 0, WB_OUT = (size_t)3072 * 1024 * 2, WB_GU = WB_OUT + (size_t)1024 * 1024 * 2, WB_DN = WB_GU + (size_t)5632 * 1024 * 2, WB_END = WB_DN + (size_t)1024 * 2816 * 2;
constexpr size_t WS_MOD = WS_WB + WB_END;
constexpr size_t WS_ROPE = WS_MOD + (size_t)4 * 5 * 6144 * 4;
constexpr size_t WS_SGW = WS_ROPE + (size_t)2 * 4352 * 64 * 4;
constexpr size_t WS_PWT = WS_SGW + (size_t)2 * 4 * 128 * 128 * 2;
constexpr size_t WS_BAR = WS_PWT + (size_t)2 * 4 * 128 * 128 * 2;
constexpr size_t WS_WM = WS_BAR + (size_t)XCD_BAR_WORDS * 4;
constexpr size_t WS_ZERO = WS_WM + (size_t)4 * 2 * 5 * 1024 * 4;
constexpr size_t WS_BIN = WS_ZERO;
constexpr size_t WS_BGU = WS_BIN + (size_t)4 * 5 * 3072 * 4;
constexpr size_t WS_RSS = WS_BGU + (size_t)4 * 5 * 5632 * 4;
constexpr size_t WS_ZEND = WS_RSS + (size_t)8 * MTOT * 4;
constexpr size_t WS_CNT = WS_ZEND;
constexpr int CNT_WORDS = 16 * 16;
constexpr size_t WS_END = WS_CNT + (size_t)CNT_WORDS * 4;
static_assert((size_t)MTOT * DFF * 2 <= WS_KV - WS_P, "ACT alias");
constexpr int LDS_WORK = 4 * 128 * 136 * 2;
constexpr int LDS_BYTES = LDS_WORK + 16;

struct Params {
    const float *x, *c, *ctx, *c_ctx, *ada_w, *ada_b, *norm_w, *even_w_in, *even_w_out, *ret_decay, *conv_w, *conv_ln_w, *conv_ln_b,
        *odd_w_in, *odd_w_out, *pool_w, *pool_scale, *sg_ln_w, *sg_ln_b, *sg_w, *sg_b, *ffn_gate, *ffn_up, *ffn_down, *final_w;
    float* out; unsigned char* ws;
};

DI int opaque_tid() { int t = threadIdx.x; asm volatile("" : "+v"(t)); return t; }
DI unsigned short f2bf(float f) { unsigned u = __float_as_uint(f); u += 0x7fffu + ((u >> 16) & 1u); return (unsigned short)(u >> 16); }
DI unsigned pack2(float lo, float hi) { return (unsigned)f2bf(lo) | ((unsigned)f2bf(hi) << 16); }
DI float bflo(unsigned u) { return __uint_as_float(u << 16); }
DI float bfhi(unsigned u) { return __uint_as_float(u & 0xffff0000u); }
DI float bf1(unsigned short u) { return __uint_as_float((unsigned)u << 16); }
DI float silu_f(float v) { return v * __builtin_amdgcn_rcpf(1.0f + __expf(-v)); }
DI float sigm_f(float v) { return __builtin_amdgcn_rcpf(1.0f + __expf(-v)); }
DI f32x4 mma(bf16x8 y, bf16x8 x, f32x4 c) { return __builtin_amdgcn_mfma_f32_16x16x32_bf16(y, x, c, 0, 0, 0); }
DI float log2_decay(const float* logit) { const float x = *logit; return -log1pf(expf(-x)) * LOG2E; }
template <int X> DI float xor_lane(float v) {
    if constexpr (X < 32) return __builtin_bit_cast(float, __builtin_amdgcn_ds_swizzle(__builtin_bit_cast(int, v), (X << 10) | 0x1f));
    else return __shfl_xor(v, 32);
}
DI float wave_sum(float v) { v += xor_lane<1>(v); v += xor_lane<2>(v); v += xor_lane<4>(v); v += xor_lane<8>(v); v += xor_lane<16>(v); v += xor_lane<32>(v); return v; }
DI int mod_set(int row) { return row < NLAT ? (row >> 12) : 4; }

struct EpiEvenIn {
    static constexpr bool PERM = true, AFTER_DRAIN = false;
    static constexpr bool STAGED = true;
    bf16_t *Q, *K, *V, *G, *U; const float* rope; const float* rss; const float* bias; ldsp ldsb;
    DI void stage(const Unit& u, ldsp lds, int wid, int lane) const {
        const float* src = wid < 4 ? rss + u.pm * 256 + wid * 64 + lane : bias + (size_t)(u.pm < 64 ? (u.pm >> 4) : 4) * 3072 + u.pn * 256 + (wid - 4) * 64 + lane;
        __builtin_amdgcn_global_load_lds((const unsigned*)src, (LAS unsigned*)(lds + pg8::STAGE_BYTES + wid * 256), 4, 0, 0);
    }
    DI void operator()(const f32x4 (&acc)[2][2][4][2], const Unit& u, int wr, int wc, int fr, int fq) const {
        const int row0 = u.pm * 256 + wr * 64 + fr, colb = u.pn * 256 + wc * 32 + 8 * fq, region = u.pn >> 1, r8 = wc * 32 + 8 * fq;
        const LAS float* sp = (const LAS float*)(ldsb + pg8::STAGE_BYTES); f32x4 bv[2][2];
#pragma unroll
        for (int bj = 0; bj < 2; ++bj) { bv[bj][0] = *(const LAS f32x4*)(sp + 256 + bj * 128 + r8); bv[bj][1] = *(const LAS f32x4*)(sp + 256 + bj * 128 + r8 + 4); }
#pragma unroll
        for (int ai = 0; ai < 2; ++ai)
#pragma unroll
            for (int m = 0; m < 4; ++m) {
                const int row = row0 + ai * 128 + m * 16; const float rs = rsqrtf(sp[ai * 128 + wr * 64 + m * 16 + fr] * (1.0f / 1024.0f) + EPS);
                const f32x4 a0 = acc[ai][0][m][0] * rs + bv[0][0], a1 = acc[ai][0][m][1] * rs + bv[0][1], b0 = acc[ai][1][m][0] * rs + bv[1][0], b1 = acc[ai][1][m][1] * rs + bv[1][1];
                if (region < 2) {
                    const int pi = row < NLAT ? (row & 4095) : 4096 + ((row - NLAT) & 255), head = (u.pn & 1) * 2 + (r8 >> 6), dd = r8 & 63;
                    const float* cp = rope + (size_t)pi * 64 + dd; const float* sp = cp + (size_t)4352 * 64;
                    const f32x4 c0 = *(const f32x4*)cp, c1 = *(const f32x4*)(cp + 4), s0 = *(const f32x4*)sp, s1 = *(const f32x4*)(sp + 4);
                    const float sc = region == 0 ? 0.08838834764831845f : 1.0f;
                    const f32x4 o10 = (a0 * c0 - b0 * s0) * sc, o11 = (a1 * c1 - b1 * s1) * sc, o20 = (a0 * s0 + b0 * c0) * sc, o21 = (a1 * s1 + b1 * c1) * sc;
                    bf16_t* dst = (region == 0 ? Q : K) + (size_t)row * 512 + head * 128 + dd;
                    u32x4 w1, w2; w1.x = pg8::cvt_pk_bf16(o10[0], o10[1]); w1.y = pg8::cvt_pk_bf16(o10[2], o10[3]); w1.z = pg8::cvt_pk_bf16(o11[0], o11[1]); w1.w = pg8::cvt_pk_bf16(o11[2], o11[3]);
                    w2.x = pg8::cvt_pk_bf16(o20[0], o20[1]); w2.y = pg8::cvt_pk_bf16(o20[2], o20[3]); w2.z = pg8::cvt_pk_bf16(o21[0], o21[1]); w2.w = pg8::cvt_pk_bf16(o21[2], o21[3]);
                    *(u32x4*)dst = w1; *(u32x4*)(dst + 64) = w2;
                } else if (region < 4) {
                    bf16_t* dst = (region == 2 ? V : G) + (size_t)row * 512 + (colb & 511);
                    u32x4 w; w.x = pg8::cvt_pk_bf16(a0[0], a0[1]); w.y = pg8::cvt_pk_bf16(a0[2], a0[3]); w.z = pg8::cvt_pk_bf16(a1[0], a1[1]); w.w = pg8::cvt_pk_bf16(a1[2], a1[3]);
                    *(u32x4*)dst = w;
                    w.x = pg8::cvt_pk_bf16(b0[0], b0[1]); w.y = pg8::cvt_pk_bf16(b0[2], b0[3]); w.z = pg8::cvt_pk_bf16(b1[0], b1[1]); w.w = pg8::cvt_pk_bf16(b1[2], b1[3]);
                    *(u32x4*)(dst + 128) = w;
                } else {
                    u32x4 w; w.x = pg8::cvt_pk_bf16(a0[0] * sigm_f(b0[0]), a0[1] * sigm_f(b0[1])); w.y = pg8::cvt_pk_bf16(a0[2] * sigm_f(b0[2]), a0[3] * sigm_f(b0[3]));
                    w.z = pg8::cvt_pk_bf16(a1[0] * sigm_f(b1[0]), a1[1] * sigm_f(b1[1])); w.w = pg8::cvt_pk_bf16(a1[2] * sigm_f(b1[2]), a1[3] * sigm_f(b1[3]));
                    *(u32x4*)(U + (size_t)row * 512 + (u.pn - 8) * 128 + r8) = w;
                }
            }
    }
};
struct EpiOddIn {
    static constexpr bool PERM = true, AFTER_DRAIN = false;
    static constexpr bool STAGED = true;
    bf16_t *PC, *Z; const float* rss; const float* bias; ldsp ldsb;
    DI void stage(const Unit& u, ldsp lds, int wid, int lane) const {
        const float* src = wid < 4 ? rss + u.pm * 256 + wid * 64 + lane : bias + (size_t)(u.pm < 64 ? (u.pm >> 4) : 4) * 1536 + u.pn * 256 + (wid - 4) * 64 + lane;
        __builtin_amdgcn_global_load_lds((const unsigned*)src, (LAS unsigned*)(lds + pg8::STAGE_BYTES + wid * 256), 4, 0, 0);
    }
    DI void operator()(const f32x4 (&acc)[2][2][4][2], const Unit& u, int wr, int wc, int fr, int fq) const {
        const int row0 = u.pm * 256 + wr * 64 + fr, colb = u.pn * 256 + wc * 32 + 8 * fq; const bool is_pc = u.pn < 2;
        const LAS float* sp = (const LAS float*)(ldsb + pg8::STAGE_BYTES); const int r8 = wc * 32 + 8 * fq; f32x4 bv[2][2];
#pragma unroll
        for (int bj = 0; bj < 2; ++bj) { bv[bj][0] = *(const LAS f32x4*)(sp + 256 + bj * 128 + r8); bv[bj][1] = *(const LAS f32x4*)(sp + 256 + bj * 128 + r8 + 4); }
#pragma unroll
        for (int ai = 0; ai < 2; ++ai)
#pragma unroll
            for (int m = 0; m < 4; ++m) {
                const int row = row0 + ai * 128 + m * 16; const float rs = rsqrtf(sp[ai * 128 + wr * 64 + m * 16 + fr] * (1.0f / 1024.0f) + EPS);
#pragma unroll
                for (int bj = 0; bj < 2; ++bj) {
                    const int c0 = colb + bj * 128; f32x4 v0 = acc[ai][bj][m][0] * rs + bv[bj][0], v1 = acc[ai][bj][m][1] * rs + bv[bj][1];
                    bf16_t* dst;
                    if (is_pc) dst = PC + (size_t)row * 512 + c0;
                    else { const f32x2 a = pg8::gelu_pk((f32x2){v0[0], v0[1]}), b = pg8::gelu_pk((f32x2){v0[2], v0[3]}), c = pg8::gelu_pk((f32x2){v1[0], v1[1]}), d = pg8::gelu_pk((f32x2){v1[2], v1[3]});
                        v0 = (f32x4){a.x, a.y, b.x, b.y}; v1 = (f32x4){c.x, c.y, d.x, d.y}; dst = Z + (size_t)row * 1024 + (c0 - 512); }
                    u32x4 w; w.x = pg8::cvt_pk_bf16(v0[0], v0[1]); w.y = pg8::cvt_pk_bf16(v0[2], v0[3]); w.z = pg8::cvt_pk_bf16(v1[0], v1[1]); w.w = pg8::cvt_pk_bf16(v1[2], v1[3]);
                    *(u32x4*)dst = w;
                }
            }
    }
};
struct EpiGU {
    static constexpr bool PERM = true, AFTER_DRAIN = false;
    static constexpr bool STAGED = true;
    bf16_t* ACT; const float* rss; const float* bias; ldsp ldsb;
    DI void stage(const Unit& u, ldsp lds, int wid, int lane) const {
        const float* src = wid < 4 ? rss + u.pm * 256 + wid * 64 + lane : bias + (size_t)(u.pm < 64 ? (u.pm >> 4) : 4) * 5632 + u.pn * 256 + (wid - 4) * 64 + lane;
        __builtin_amdgcn_global_load_lds((const unsigned*)src, (LAS unsigned*)(lds + pg8::STAGE_BYTES + wid * 256), 4, 0, 0);
    }
    DI void operator()(const f32x4 (&acc)[2][2][4][2], const Unit& u, int wr, int wc, int fr, int fq) const {
        const int row0 = u.pm * 256 + wr * 64 + fr, colb = u.pn * 256 + wc * 32 + 8 * fq, ff = u.pn * 128 + wc * 32 + 8 * fq;
        const LAS float* sp = (const LAS float*)(ldsb + pg8::STAGE_BYTES); const int r8 = wc * 32 + 8 * fq; f32x4 bv[2][2];
#pragma unroll
        for (int bj = 0; bj < 2; ++bj) { bv[bj][0] = *(const LAS f32x4*)(sp + 256 + bj * 128 + r8); bv[bj][1] = *(const LAS f32x4*)(sp + 256 + bj * 128 + r8 + 4); }
#pragma unroll
        for (int ai = 0; ai < 2; ++ai)
#pragma unroll
            for (int m = 0; m < 4; ++m) {
                const int row = row0 + ai * 128 + m * 16; const float rs = rsqrtf(sp[ai * 128 + wr * 64 + m * 16 + fr] * (1.0f / 1024.0f) + EPS);
                const f32x4 g0 = acc[ai][0][m][0] * rs + bv[0][0], g1 = acc[ai][0][m][1] * rs + bv[0][1], u0 = acc[ai][1][m][0] * rs + bv[1][0], u1 = acc[ai][1][m][1] * rs + bv[1][1];
                u32x4 w; w.x = pg8::cvt_pk_bf16(silu_f(g0[0]) * u0[0], silu_f(g0[1]) * u0[1]); w.y = pg8::cvt_pk_bf16(silu_f(g0[2]) * u0[2], silu_f(g0[3]) * u0[3]);
                w.z = pg8::cvt_pk_bf16(silu_f(g1[0]) * u1[0], silu_f(g1[1]) * u1[1]); w.w = pg8::cvt_pk_bf16(silu_f(g1[2]) * u1[2], silu_f(g1[3]) * u1[3]);
                *(u32x4*)(ACT + (size_t)row * DFF + ff) = w;
            }
    }
};
struct EpiRes {
    static constexpr bool PERM = true, AFTER_DRAIN = false, STAGED = true;
    const float* in_lat; const float* in_ctx; float* X; const float* gate;
    bf16_t* Hn; const float* wm; float* rss; ldsp ldsb;
    DI void stage(const Unit& u, ldsp lds, int wid, int lane) const {
        const int set = u.pm < 64 ? (u.pm >> 4) : 4;
        const float* src = wid < 4 ? gate + (size_t)set * 6144 + u.pn * 256 + wid * 64 + lane : wm + (size_t)set * 1024 + u.pn * 256 + (wid - 4) * 64 + lane;
        __builtin_amdgcn_global_load_lds((const unsigned*)src, (LAS unsigned*)(lds + pg8::STAGE_BYTES + wid * 256), 4, 0, 0);
    }
    DI void operator()(const f32x4 (&acc)[2][2][4][2], const Unit& u, int wr, int wc, int fr, int fq) const {
        const int row0 = u.pm * 256 + wr * 64 + fr, r8 = wc * 32 + 8 * fq, col0 = u.pn * 256 + r8;
        const float* ib = u.pm < 64 ? in_lat + (size_t)row0 * D + col0 : in_ctx + (size_t)(row0 - NLAT) * D + col0;
        const LAS float* sp = (const LAS float*)(ldsb + pg8::STAGE_BYTES) + r8;
#pragma unroll
        for (int ai = 0; ai < 2; ++ai) {
            f32x4 xin[4][2][2];
#pragma unroll
            for (int m = 0; m < 4; ++m) { const float* inp = ib + (size_t)(ai * 128 + m * 16) * D;
#pragma unroll
                for (int bj = 0; bj < 2; ++bj) { xin[m][bj][0] = *(const f32x4*)(inp + bj * 128); xin[m][bj][1] = *(const f32x4*)(inp + bj * 128 + 4); } }
#pragma unroll
            for (int m = 0; m < 4; ++m) { const int row = row0 + ai * 128 + m * 16; float* rowp = X + (size_t)row * D + col0; float ssq = 0.f;
#pragma unroll
                for (int bj = 0; bj < 2; ++bj) {
                    const f32x4 g0 = *(const LAS f32x4*)(sp + bj * 128), g1 = *(const LAS f32x4*)(sp + bj * 128 + 4);
                    const f32x4 x0 = xin[m][bj][0] + g0 * acc[ai][bj][m][0], x1 = xin[m][bj][1] + g1 * acc[ai][bj][m][1];
                    *(f32x4*)(rowp + bj * 128) = x0; *(f32x4*)(rowp + bj * 128 + 4) = x1;
                    if (Hn) { ssq += (x0[0] * x0[0] + x0[1] * x0[1] + x0[2] * x0[2] + x0[3] * x0[3]) + (x1[0] * x1[0] + x1[1] * x1[1] + x1[2] * x1[2] + x1[3] * x1[3]);
                        const f32x4 w0 = *(const LAS f32x4*)(sp + 256 + bj * 128), w1 = *(const LAS f32x4*)(sp + 256 + bj * 128 + 4);
                        const f32x4 a0 = x0 * w0, a1 = x1 * w1; u32x4 h; h.x = pg8::cvt_pk_bf16(a0[0], a0[1]); h.y = pg8::cvt_pk_bf16(a0[2], a0[3]); h.z = pg8::cvt_pk_bf16(a1[0], a1[1]); h.w = pg8::cvt_pk_bf16(a1[2], a1[3]);
                        *(u32x4*)(Hn + (size_t)row * D + col0 + bj * 128) = h; } }
                if (Hn) { ssq += xor_lane<16>(ssq); ssq += xor_lane<32>(ssq); if (fq == 0) __hip_atomic_fetch_add(rss + row, ssq, __ATOMIC_RELAXED, __HIP_MEMORY_SCOPE_AGENT); } }
            asm volatile("" ::: "memory"); }
    }
};

template <class Epi> DI void run_gemm(ldsp lds, const bf16_t* A, const bf16_t* Bt, int M, int N, int K, const Epi& E) {
    pg8::Gemm g{A, Bt, M, N, K}; pg8::StaticOrder S; S.init(M, N, (int)gridDim.x, (int)blockIdx.x);
    pg8::gemm_phase<Epi, pg8::StaticOrder, false>(lds, g, S, E, nullptr);
}

DI void static_map(int wgid, int nM, int nN, Unit& u) {
    const int nwg = nM * nN; { const int q = nwg / 8, r = nwg % 8, xcd = wgid % 8, off = wgid / 8; wgid = (xcd < r ? xcd * (q + 1) : r * (q + 1) + (xcd - r) * q) + off; }
    const int nig = 8 * nN, gid = wgid / nig, fm = gid * 8, gsz = (nM - fm) < 8 ? (nM - fm) : 8;
    u.pm = fm + ((wgid % nig) % gsz); u.pn = (wgid % nig) / gsz;
}
DI void publish_wave(unsigned* cnt) {
    __builtin_amdgcn_fence(__ATOMIC_RELEASE, "agent"); asm volatile("s_waitcnt vmcnt(0)" ::: "memory");
    if ((threadIdx.x & 63) == 0) __hip_atomic_fetch_add(cnt, 1u, __ATOMIC_RELAXED, __HIP_MEMORY_SCOPE_AGENT);
}
DI void wait_count(unsigned* cnt, unsigned need) {
    if (threadIdx.x == 0) { unsigned sp = 0; while (__hip_atomic_load(cnt, __ATOMIC_RELAXED, __HIP_MEMORY_SCOPE_AGENT) < need && ++sp < (1u << 22)) __builtin_amdgcn_s_sleep(2); }
    __syncthreads();
    __builtin_amdgcn_fence(__ATOMIC_ACQUIRE, "agent"); asm volatile("s_waitcnt vmcnt(0)" ::: "memory");
    __syncthreads();
}
DI void publish_block(unsigned* cnt) {
    __builtin_amdgcn_fence(__ATOMIC_RELEASE, "agent"); asm volatile("s_waitcnt vmcnt(0)" ::: "memory");
    __syncthreads();
    if (threadIdx.x == 0) __hip_atomic_fetch_add(cnt, 1u, __ATOMIC_RELAXED, __HIP_MEMORY_SCOPE_AGENT);
}
struct CtxFirstOrder {
    int nN, c, nctx, ntot, spec; unsigned* cnt;
    DI bool next(int i, Unit& u) const {
        const int nreg = ntot - spec; int L;
        if (c < 240) { L = i * 240 + c; if (L >= nreg) return false; } else { L = nreg + i * 16 + (c - 240); if (L >= ntot) return false; }
        if (L < nctx) { u.pm = 64 + L / nN; u.pn = L % nN; } else static_map(L - nctx, 64, nN, u);
        return true;
    }
    DI void a_ready(const Unit&) const {}
    DI void done(const Unit& u) const { if (u.pm >= 64) publish_wave(cnt); }
};
struct OneUnitOrder { int pm, pn; DI bool next(int i, Unit& u) const { u.pm = pm; u.pn = pn; return i == 0; } DI void a_ready(const Unit&) const {} DI void done(const Unit&) const {} };

DI void ph_init(const Params& P, ldsp lds) {
    const int tid = opaque_tid(), G = gridDim.x, bid = blockIdx.x;
    float* mod = (float*)(P.ws + WS_MOD); float* wmt = (float*)(P.ws + WS_WM);
    LAS float* sc = (LAS float*)lds;
    LAS float* red = (LAS float*)(lds + 5 * 1024 * 4);
    if (bid < 192) {
        for (int idx = tid; idx < 5120; idx += 512) { const int s = idx >> 10, k = idx & 1023; const float v = s < 4 ? P.c[s * 1024 + k] : P.c_ctx[k]; sc[idx] = silu_f(v); }
        __syncthreads();
        for (int u = bid; u < 192; u += G) {
            const int l = u / 48, cb = u % 48, c4 = (tid & 31) * 4, kq = tid >> 5;
            const float* wp = P.ada_w + ((size_t)l * 1024 + kq * 64) * 6144 + cb * 128 + c4;
            f32x4 a0 = (f32x4){0.f, 0.f, 0.f, 0.f}, a1 = a0, a2 = a0, a3 = a0, a4 = a0;
#pragma unroll 8
            for (int k = 0; k < 64; ++k) { const f32x4 w = *(const f32x4*)(wp + (size_t)k * 6144); const int kk = kq * 64 + k;
                a0 += w * sc[kk]; a1 += w * sc[1024 + kk]; a2 += w * sc[2048 + kk]; a3 += w * sc[3072 + kk]; a4 += w * sc[4096 + kk]; }
            *(LAS f32x4*)(red + (kq * 5 + 0) * 128 + c4) = a0; *(LAS f32x4*)(red + (kq * 5 + 1) * 128 + c4) = a1; *(LAS f32x4*)(red + (kq * 5 + 2) * 128 + c4) = a2;
            *(LAS f32x4*)(red + (kq * 5 + 3) * 128 + c4) = a3; *(LAS f32x4*)(red + (kq * 5 + 4) * 128 + c4) = a4;
            __syncthreads();
            for (int idx = tid; idx < 640; idx += 512) { const int s = idx >> 7, c2 = idx & 127; float v = P.ada_b[l * 6144 + cb * 128 + c2];
#pragma unroll
                for (int kk = 0; kk < 16; ++kk) v += red[(kk * 5 + s) * 128 + c2];
                mod[((size_t)l * 5 + s) * 6144 + cb * 128 + c2] = v;
                const int n = cb * 128 + c2, mch = n >> 10, col = n & 1023;
                if (mch == 1) wmt[(((size_t)l * 2 + 0) * 5 + s) * 1024 + col] = P.norm_w[(l * 2 + 0) * 1024 + col] * (1.0f + v);
                if (mch == 4) wmt[(((size_t)l * 2 + 1) * 5 + s) * 1024 + col] = P.norm_w[(l * 2 + 1) * 1024 + col] * (1.0f + v); }
            __syncthreads();
        }
    }
    { float* rc = (float*)(P.ws + WS_ROPE); float* rs = rc + 4352 * 64;
      for (int idx = bid * 512 + tid; idx < 4352 * 64; idx += G * 512) { const int pi = idx >> 6, d = idx & 63;
          float ps, pr, pc; if (pi < 4096) { ps = 256.f; pr = (float)(pi >> 6); pc = (float)(pi & 63); } else { ps = (float)(pi - 4096); pr = 0.f; pc = 0.f; }
          float ang; if (d < 16) ang = ps * powf(10000.f, -(float)d / 16.f); else if (d < 40) ang = pr * powf(10000.f, -(float)(d - 16) / 24.f); else ang = pc * powf(10000.f, -(float)(d - 40) / 24.f);
          float sv, cv; sincosf(ang, &sv, &cv); rc[idx] = cv; rs[idx] = sv; } }
    { bf16_t* sgw = (bf16_t*)(P.ws + WS_SGW); bf16_t* pwt = (bf16_t*)(P.ws + WS_PWT);
      for (int idx = bid * 512 + tid; idx < 2 * 4 * 128 * 128; idx += G * 512) { sgw[idx] = f2bf(P.sg_w[idx]);
          const int jg = idx >> 14, dd = (idx >> 7) & 127, cc = idx & 127; pwt[idx] = f2bf(P.pool_w[(size_t)jg * 16384 + cc * 128 + dd]); } }
}

DI const float* src_col(int mode, int p, const float* a, const float* b) {
    if (mode == 0) return a + p;
    const int U = p >> 8, r = p & 255;
    if (mode == 1) {
        if (p < 1024) { const int which = (r & 127) >> 6, dd = r & 63; return a + U * 256 + which * 128 + (r < 128 ? 0 : 64) + dd; }
        if (p < 2048) return a + p;
        return r < 128 ? a + 2048 + (U - 8) * 128 + r : a + 2560 + (U - 8) * 128 + (r - 128);
    }
    return r < 128 ? a + U * 128 + r : b + U * 128 + (r - 128);
}
DI void convert_w(ldsp lds, bf16_t* dst, int K, int Np, int ld, int mode, const float* a, const float* b, int& tile_ctr, int rank, int G, const float* shift, float* bias) {
    LAS float* tile = (LAS float*)lds;
    LAS float* red = (LAS float*)(lds + 64 * 260 * 4);
    const int npt = Np / 64, nkt = K / 256, ntiles = npt * nkt;
    int first = (rank - tile_ctr % G + G) % G;
    for (int t = first; t < ntiles; t += G) {
        const int pt = t % npt, kt = t / npt, p0 = pt * 64, k0 = kt * 256; const int tid = opaque_tid();
        { const int pg = tid & 15, kk = tid >> 4; const float* col = src_col(mode, p0 + 4 * pg, a, b) + (size_t)(k0 + kk) * ld; f32x4 v[8];
#pragma unroll
          for (int i = 0; i < 8; ++i) v[i] = *(const f32x4*)(col + (size_t)(32 * i) * ld);
#pragma unroll
          for (int i = 0; i < 8; ++i) { const int k = kk + 32 * i;
#pragma unroll
              for (int e = 0; e < 4; ++e) tile[(4 * pg + e) * 260 + k] = v[i][e]; }
          if (shift) { f32x4 pb[5];
#pragma unroll
              for (int s = 0; s < 5; ++s) { pb[s] = (f32x4){0.f, 0.f, 0.f, 0.f};
#pragma unroll
                  for (int i = 0; i < 8; ++i) pb[s] += v[i] * shift[s * 6144 + k0 + kk + 32 * i];
#pragma unroll
                  for (int e = 0; e < 4; ++e) { float x = pb[s][e]; x += xor_lane<16>(x); x += xor_lane<32>(x); pb[s][e] = x; } }
              if ((tid & 63) < 16) {
#pragma unroll
                  for (int s = 0; s < 5; ++s) *(LAS f32x4*)(red + ((tid >> 6) * 16 + pg) * 20 + 4 * s) = pb[s]; } } }
        __syncthreads();
        { const int k8 = tid & 31, pr = tid >> 5;
#pragma unroll
          for (int i = 0; i < 4; ++i) { const int p = pr + 16 * i; const f32x4 lo = *(const LAS f32x4*)(tile + p * 260 + 8 * k8), hi = *(const LAS f32x4*)(tile + p * 260 + 8 * k8 + 4);
              u32x4 o; o.x = pack2(lo[0], lo[1]); o.y = pack2(lo[2], lo[3]); o.z = pack2(hi[0], hi[1]); o.w = pack2(hi[2], hi[3]);
              *(u32x4*)(dst + (size_t)(p0 + p) * K + k0 + 8 * k8) = o; }
          if (shift && tid < 320) { const int s = tid >> 6, p = tid & 63, pg = p >> 2, e2 = p & 3; float x = 0.f;
#pragma unroll
              for (int w = 0; w < 8; ++w) x += red[(w * 16 + pg) * 20 + 4 * s + e2];
              __hip_atomic_fetch_add(bias + (size_t)s * Np + p0 + p, x, __ATOMIC_RELAXED, __HIP_MEMORY_SCOPE_AGENT); } }
        __syncthreads();
    }
    tile_ctr += ntiles;
}

DI void ph_norm0(const Params& P) {
    const int tid = opaque_tid(), lane = tid & 63, wv = tid >> 6, G = gridDim.x;
    bf16_t* H = (bf16_t*)(P.ws + WS_H); const float* wmt = (const float*)(P.ws + WS_WM); float* rss = (float*)(P.ws + WS_RSS);
    for (int row = (blockIdx.x * 8 + wv) * 2; row < MTOT; row += G * 16) {
        f32x4 v[2][4];
#pragma unroll
        for (int rr = 0; rr < 2; ++rr) { const int r = row + rr; const f32x4* xp = (const f32x4*)(r < NLAT ? P.x + (size_t)r * D : P.ctx + (size_t)(r - NLAT) * D);
#pragma unroll
            for (int j = 0; j < 4; ++j) v[rr][j] = xp[j * 64 + lane]; }
        const float* ws_ = wmt + (size_t)mod_set(row) * 1024;
#pragma unroll
        for (int rr = 0; rr < 2; ++rr) { float ss = 0.f;
#pragma unroll
            for (int j = 0; j < 4; ++j) ss += v[rr][j][0] * v[rr][j][0] + v[rr][j][1] * v[rr][j][1] + v[rr][j][2] * v[rr][j][2] + v[rr][j][3] * v[rr][j][3];
            ss = wave_sum(ss); if (lane == 0) rss[row + rr] = ss;
#pragma unroll
            for (int j = 0; j < 4; ++j) { const int c = (j * 64 + lane) * 4; const f32x4 h = v[rr][j] * *(const f32x4*)(ws_ + c); u32x2 o; o.x = pack2(h[0], h[1]); o.y = pack2(h[2], h[3]); *(u32x2*)(H + (size_t)(row + rr) * D + c) = o; } }
    }
}
DI void convert_inout(const Params& P, ldsp lds, int layer) {
    unsigned char* wb = P.ws + WS_WB; const int j = layer >> 1, G = gridDim.x, rank = (int)blockIdx.x; int ctr = 0;
    const float* shift = (const float*)(P.ws + WS_MOD) + (size_t)layer * 5 * 6144; float* bias = (float*)(P.ws + WS_BIN) + (size_t)layer * 5 * 3072;
    if (!(layer & 1)) { convert_w(lds, (bf16_t*)(wb + WB_IN), 1024, 3072, 3072, 1, P.even_w_in + (size_t)j * 1024 * 3072, nullptr, ctr, rank, G, shift, bias);
                        convert_w(lds, (bf16_t*)(wb + WB_OUT), 1024, 1024, 1024, 0, P.even_w_out + (size_t)j * 1024 * 1024, nullptr, ctr, rank, G, nullptr, nullptr); }
    else { convert_w(lds, (bf16_t*)(wb + WB_IN), 1024, 1536, 1536, 0, P.odd_w_in + (size_t)j * 1024 * 1536, nullptr, ctr, rank, G, shift, bias);
           convert_w(lds, (bf16_t*)(wb + WB_OUT), 1024, 1024, 1024, 0, P.odd_w_out + (size_t)j * 1024 * 1024, nullptr, ctr, rank, G, nullptr, nullptr); }
}
DI void convert_ffn_w(const Params& P, ldsp lds, int layer, int rank, int nidle);
DI void convert_ffn(const Params& P, ldsp lds, int layer, int nunits) {
    const int G = gridDim.x, busy = nunits % G, nidle = busy ? G - busy : G;
    convert_ffn_w(P, lds, layer, (int)blockIdx.x - (G - nidle), nidle);
}
DI void convert_ffn_w(const Params& P, ldsp lds, int layer, int rank, int nidle) {
    if (rank < 0 || rank >= nidle) return;
    unsigned char* wb = P.ws + WS_WB; int ctr = 0;
    convert_w(lds, (bf16_t*)(wb + WB_GU), 1024, 5632, 2816, 2, P.ffn_gate + (size_t)layer * 1024 * 2816, P.ffn_up + (size_t)layer * 1024 * 2816, ctr, rank, nidle,
              (const float*)(P.ws + WS_MOD) + (size_t)layer * 5 * 6144 + 3 * 1024, (float*)(P.ws + WS_BGU) + (size_t)layer * 5 * 5632);
    convert_w(lds, (bf16_t*)(wb + WB_DN), 2816, 1024, 1024, 0, P.ffn_down + (size_t)layer * 2816 * 1024, nullptr, ctr, rank, nidle, nullptr, nullptr);
}

DI int chunk_row0(int b, int chunk) { return chunk < 2 ? NLAT + b * 256 + chunk * 128 : b * 4096 + (chunk - 2) * 128; }
DI void ret_kv_unit(const Params& P, ldsp lds, int j, int unit) {
    const int tid = opaque_tid(), lane = tid & 63, wv = tid >> 6, r = lane & 15, q = lane >> 4;
    const int bh = unit / 34, chunk = unit % 34, b = bh >> 2, h = bh & 3, row0 = chunk_row0(b, chunk);
    const float l2f = log2_decay(P.ret_decay + j * 8 + h), l2b = log2_decay(P.ret_decay + j * 8 + 4 + h);
    const bf16_t* Kb = (const bf16_t*)(P.ws + WS_P + SZ_HALF); const bf16_t* Vb = (const bf16_t*)(P.ws + WS_P + 2 * SZ_HALF);
    LAS unsigned short* KT = (LAS unsigned short*)lds; LAS unsigned short* VTf = KT + 128 * 136; LAS unsigned short* VTb = VTf + 128 * 136;
    { const int m = tid & 127, dq = tid >> 7; const float zf = exp2f(l2f * (float)(127 - m)), zb = exp2f(l2b * (float)m);
#pragma unroll
      for (int c4 = 0; c4 < 4; ++c4) { const int d0 = (dq * 4 + c4) * 8; const size_t go = (size_t)(row0 + m) * 512 + h * 128 + d0;
          const u32x4 kk = *(const u32x4*)(Kb + go), vv = *(const u32x4*)(Vb + go);
#pragma unroll
          for (int e = 0; e < 8; ++e) { const unsigned kw = kk[e >> 1], vw = vv[e >> 1]; const unsigned short ks = (e & 1) ? (unsigned short)(kw >> 16) : (unsigned short)(kw & 0xffffu);
              const float vf = (e & 1) ? bfhi(vw) : bflo(vw);
              KT[(d0 + e) * 136 + m] = ks; VTf[(d0 + e) * 136 + m] = f2bf(vf * zf); VTb[(d0 + e) * 136 + m] = f2bf(vf * zb); } } }
    __syncthreads();
    f32x4 af[8], ab[8];
#pragma unroll
    for (int n = 0; n < 8; ++n) { af[n] = (f32x4){0.f, 0.f, 0.f, 0.f}; ab[n] = (f32x4){0.f, 0.f, 0.f, 0.f}; }
#pragma unroll
    for (int s = 0; s < 4; ++s) {
        const bf16x8 xf = *(const LAS bf16x8*)(VTf + (16 * wv + r) * 136 + 32 * s + 8 * q), xb = *(const LAS bf16x8*)(VTb + (16 * wv + r) * 136 + 32 * s + 8 * q);
#pragma unroll
        for (int n = 0; n < 8; ++n) { const bf16x8 y = *(const LAS bf16x8*)(KT + (16 * n + r) * 136 + 32 * s + 8 * q); af[n] = mma(y, xf, af[n]); ab[n] = mma(y, xb, ab[n]); }
    }
    bf16_t* kvf = (bf16_t*)(P.ws + WS_KV) + ((size_t)(bh * 34 + chunk) * 2) * 16384 + (size_t)(16 * wv + r) * 128 + 4 * q; bf16_t* kvb = kvf + 16384;
#pragma unroll
    for (int n = 0; n < 8; ++n) { u32x2 wf, wb2; wf.x = pack2(af[n][0], af[n][1]); wf.y = pack2(af[n][2], af[n][3]); wb2.x = pack2(ab[n][0], ab[n][1]); wb2.y = pack2(ab[n][2], ab[n][3]);
        *(u32x2*)(kvf + 16 * n) = wf; *(u32x2*)(kvb + 16 * n) = wb2; }
    __syncthreads();
}
DI void conv_unit(const Params& P, ldsp lds, int j, int ct) {
    const int tid = opaque_tid(), lane = tid & 63, wv = tid >> 6;
    const bf16_t* U = (const bf16_t*)(P.ws + WS_P + 4 * SZ_HALF); bf16_t* MIX = (bf16_t*)(P.ws + WS_MIX);
    const int row0 = ct * 32; int s0, len; if (row0 < NLAT) { s0 = row0 & ~4095; len = 4096; } else { s0 = NLAT + ((row0 - NLAT) & ~255); len = 256; }
    LAS unsigned* uw = (LAS unsigned*)lds;
    LAS float* wl = (LAS float*)(lds + 32 * 516 * 4);
    LAS float* cb = (LAS float*)lds;
#pragma unroll
    for (int it = 0; it < 8; ++it) { const int idx = tid + 512 * it; if (idx < 62 * 64) { const int rr = row0 - 15 + (idx >> 6), ch = idx & 63;
        u32x4 v = (u32x4){0u, 0u, 0u, 0u}; if (rr >= s0 && rr < s0 + len) v = *(const u32x4*)(U + (size_t)rr * 512 + ch * 8);
        *(LAS u32x4*)(uw + (idx >> 6) * 256 + ch * 4) = v; } }
    __syncthreads();
    const int cp = tid & 255, half = tid >> 8;
    f32x2 acc2[16];
#pragma unroll
    for (int th = 0; th < 2; ++th) { f32x2 xw[38];
#pragma unroll
      for (int i = 0; i < 38; ++i) { const unsigned w = uw[(16 * half + 8 * th + i) * 256 + cp]; xw[i] = (f32x2){bflo(w), bfhi(w)}; }
#pragma unroll
      for (int t = 0; t < 8; ++t) acc2[8 * th + t] = (f32x2){0.f, 0.f};
#pragma unroll
      for (int k = 0; k < 31; ++k) { const f32x2 w = *(const LAS f32x2*)(wl + k * 512 + 2 * cp);
#pragma unroll
          for (int t = 0; t < 8; ++t) acc2[8 * th + t] = acc2[8 * th + t] + w * xw[t + k]; }
      asm volatile("" ::: "memory"); }
    __syncthreads();
#pragma unroll
    for (int t = 0; t < 16; ++t) *(LAS f32x2*)(cb + (16 * half + t) * 516 + 2 * cp) = acc2[t];
    __syncthreads();
    { const f32x4 lw0 = *(const f32x4*)(P.conv_ln_w + j * 512 + 8 * lane), lw1 = *(const f32x4*)(P.conv_ln_w + j * 512 + 8 * lane + 4);
      const f32x4 lb0 = *(const f32x4*)(P.conv_ln_b + j * 512 + 8 * lane), lb1 = *(const f32x4*)(P.conv_ln_b + j * 512 + 8 * lane + 4);
#pragma unroll
      for (int tt = 0; tt < 4; ++tt) { const int tok = 4 * wv + tt;
          f32x4 v0 = *(const LAS f32x4*)(cb + tok * 516 + 8 * lane), v1 = *(const LAS f32x4*)(cb + tok * 516 + 8 * lane + 4);
          const float mean = wave_sum(v0[0] + v0[1] + v0[2] + v0[3] + v1[0] + v1[1] + v1[2] + v1[3]) * (1.0f / 512.0f);
          v0 = v0 - mean; v1 = v1 - mean;
          const float var = wave_sum(v0[0] * v0[0] + v0[1] * v0[1] + v0[2] * v0[2] + v0[3] * v0[3] + v1[0] * v1[0] + v1[1] * v1[1] + v1[2] * v1[2] + v1[3] * v1[3]) * (1.0f / 512.0f);
          const float rstd = rsqrtf(var + EPS);
          v0 = v0 * rstd * lw0 + lb0; v1 = v1 * rstd * lw1 + lb1;
          u32x4 o; o.x = pack2(silu_f(v0[0]), silu_f(v0[1])); o.y = pack2(silu_f(v0[2]), silu_f(v0[3])); o.z = pack2(silu_f(v1[0]), silu_f(v1[1])); o.w = pack2(silu_f(v1[2]), silu_f(v1[3]));
          *(u32x4*)(MIX + (size_t)(row0 + tok) * D + 512 + 8 * lane) = o; } }
    __syncthreads();
}
DI void ph_ret_kv_conv(const Params& P, ldsp lds, int j, int n_conv_tiles) {
    const int G = gridDim.x;
    for (int u = blockIdx.x; u < 544; u += G) ret_kv_unit(P, lds, j, u);
    if (G - 1 - (int)blockIdx.x < n_conv_tiles) { const int tid = opaque_tid(); LAS float* wl = (LAS float*)(lds + 32 * 516 * 4);
#pragma unroll
        for (int it = 0; it < 8; ++it) { const int idx = tid + 512 * it; if (idx < 31 * 128) *(LAS f32x4*)(wl + idx * 4) = *(const f32x4*)(P.conv_w + (size_t)j * 31 * 512 + idx * 4); } }
    for (int u = G - 1 - (int)blockIdx.x; u < n_conv_tiles; u += G) conv_unit(P, lds, j, u);
}
template <class EpiT> DI void ph_ret_kv_conv_ho(const Params& P, ldsp lds, int j, int layer, int nG, bool ctx_conv, const EpiT& E, unsigned* cnt) {
    const int c = (int)blockIdx.x;
    if (c < nG) { const int pm = layer == 0 ? 64 + c / 12 : 64 + c / 4, pn = layer == 0 ? c % 12 : 2 + c % 4;
        pg8::Gemm g{(const bf16_t*)(P.ws + WS_H), (const bf16_t*)(P.ws + WS_WB + WB_IN), MTOT, 3072, 1024}; OneUnitOrder S{pm, pn};
        pg8::gemm_phase<EpiT, OneUnitOrder, false>(lds, g, S, E, nullptr);
        publish_block(cnt); }
    for (int k = 0; k < 2; ++k) { const int u = c + 256 * k; ret_kv_unit(P, lds, j, (u >> 5) * 34 + 2 + (u & 31)); }
    { const int tid = opaque_tid(); LAS float* wl = (LAS float*)(lds + 32 * 516 * 4);
#pragma unroll
      for (int it = 0; it < 8; ++it) { const int idx = tid + 512 * it; if (idx < 31 * 128) *(LAS f32x4*)(wl + idx * 4) = *(const f32x4*)(P.conv_w + (size_t)j * 31 * 512 + idx * 4); } }
    if (c >= nG) { conv_unit(P, lds, j, 255 - c); conv_unit(P, lds, j, 511 - c); }
    if (c >= 48 && c < 48 + 2 * nG) { const int k = c - 48, cc = k >> 1; conv_unit(P, lds, j, (k & 1) ? 511 - cc : 255 - cc); }
    if (c >= 144 && c < 176) { wait_count(cnt, (unsigned)nG); const int u2 = c - 144; ret_kv_unit(P, lds, j, (u2 >> 1) * 34 + (u2 & 1)); }
    if (ctx_conv && c >= 176 && c < 208) { wait_count(cnt, (unsigned)nG); conv_unit(P, lds, j, 512 + (c - 176)); }
}
constexpr size_t KV_HALF = (size_t)16 * 34 * 2 * 16384 * 2;
DI void ph_scan(const Params& P, int j) {
    const u32x4* kv = (const u32x4*)(P.ws + WS_KV); u32x4* sp = (u32x4*)(P.ws + WS_KV + KV_HALF);
    for (int idx = blockIdx.x * 512 + opaque_tid(); idx < 16 * 2 * 2048; idx += gridDim.x * 512) {
        const int bh = idx >> 12, dir = (idx >> 11) & 1, e8 = idx & 2047, h = bh & 3;
        const float dec = exp2f(128.0f * log2_decay(P.ret_decay + j * 8 + dir * 4 + h));
        float carry[8];
#pragma unroll
        for (int e = 0; e < 8; ++e) carry[e] = 0.f;
#pragma unroll 1
        for (int k0 = 0; k0 < 34; k0 += 17) { u32x4 v[17];
#pragma unroll
            for (int i = 0; i < 17; ++i) { const int k = k0 + i, c = dir == 0 ? k : (k < 2 ? 1 - k : 35 - k); v[i] = kv[((size_t)(bh * 34 + c) * 2 + dir) * 2048 + e8]; }
#pragma unroll
            for (int i = 0; i < 17; ++i) { const int k = k0 + i, c = dir == 0 ? k : (k < 2 ? 1 - k : 35 - k);
                u32x4 o; o.x = pack2(carry[0], carry[1]); o.y = pack2(carry[2], carry[3]); o.z = pack2(carry[4], carry[5]); o.w = pack2(carry[6], carry[7]);
                sp[((size_t)(bh * 34 + c) * 2 + dir) * 2048 + e8] = o;
                carry[0] = carry[0] * dec + bflo(v[i].x); carry[1] = carry[1] * dec + bfhi(v[i].x); carry[2] = carry[2] * dec + bflo(v[i].y); carry[3] = carry[3] * dec + bfhi(v[i].y);
                carry[4] = carry[4] * dec + bflo(v[i].z); carry[5] = carry[5] * dec + bfhi(v[i].z); carry[6] = carry[6] * dec + bflo(v[i].w); carry[7] = carry[7] * dec + bfhi(v[i].w); } }
    }
}
DI void ret_out_unit(const Params& P, ldsp lds, int j, int bh, int chunk, unsigned* cnt) {
    const int tid = opaque_tid(), lane = tid & 63, wv = tid >> 6, r = lane & 15, q = lane >> 4;
    const int b = bh >> 2, h = bh & 3, row0 = chunk_row0(b, chunk);
    const float l2f = log2_decay(P.ret_decay + j * 8 + h), l2b = log2_decay(P.ret_decay + j * 8 + 4 + h);
    const bf16_t* Qb = (const bf16_t*)(P.ws + WS_P); const bf16_t* Kb = (const bf16_t*)(P.ws + WS_P + SZ_HALF); const bf16_t* Vb = (const bf16_t*)(P.ws + WS_P + 2 * SZ_HALF);
    const bf16_t* Gb = (const bf16_t*)(P.ws + WS_P + 3 * SZ_HALF); bf16_t* MIX = (bf16_t*)(P.ws + WS_MIX);
    LAS unsigned short* Ks = (LAS unsigned short*)lds; LAS unsigned short* VT = Ks + 128 * 136; LAS unsigned short* SfT = VT + 128 * 136; LAS unsigned short* SbT = SfT + 128 * 136;
#pragma unroll
    for (int it = 0; it < 4; ++it) { const int idx = tid + 512 * it, jj = idx >> 4, ch = idx & 15;
        *(LAS u32x4*)(Ks + jj * 136 + ch * 8) = *(const u32x4*)(Kb + (size_t)(row0 + jj) * 512 + h * 128 + ch * 8); }
    { const int m = tid & 127, dq = tid >> 7;
#pragma unroll
      for (int c4 = 0; c4 < 4; ++c4) { const int d0 = (dq * 4 + c4) * 8; const u32x4 vv = *(const u32x4*)(Vb + (size_t)(row0 + m) * 512 + h * 128 + d0);
#pragma unroll
          for (int e = 0; e < 8; ++e) { const unsigned vw = vv[e >> 1]; VT[(d0 + e) * 136 + m] = (e & 1) ? (unsigned short)(vw >> 16) : (unsigned short)(vw & 0xffffu); } } }
    { const bf16_t* sf = (const bf16_t*)(P.ws + WS_KV + KV_HALF) + ((size_t)(bh * 34 + chunk) * 2) * 16384; const bf16_t* sb = sf + 16384;
#pragma unroll
      for (int it = 0; it < 4; ++it) { const int idx = tid + 512 * it, e = idx >> 4, ch = idx & 15;
          *(LAS u32x4*)(SfT + e * 136 + ch * 8) = *(const u32x4*)(sf + e * 128 + ch * 8); *(LAS u32x4*)(SbT + e * 136 + ch * 8) = *(const u32x4*)(sb + e * 128 + ch * 8); } }
    const int i = 16 * wv + r; const size_t grow = (size_t)(row0 + i);
    bf16x8 xq[4];
#pragma unroll
    for (int s = 0; s < 4; ++s) xq[s] = *(const bf16x8*)(Qb + grow * 512 + h * 128 + 32 * s + 8 * q);
    __syncthreads();
    f32x4 sc[8];
#pragma unroll
    for (int jt = 0; jt < 8; ++jt) { sc[jt] = (f32x4){0.f, 0.f, 0.f, 0.f};
#pragma unroll
        for (int s = 0; s < 4; ++s) { const bf16x8 y = *(const LAS bf16x8*)(Ks + (16 * jt + r) * 136 + 32 * s + 8 * q); sc[jt] = mma(y, xq[s], sc[jt]); } }
    bf16x8 xp[4];
#pragma unroll
    for (int s = 0; s < 4; ++s) { u32x4 w;
#pragma unroll
        for (int half = 0; half < 2; ++half) { const int jt = 2 * s + half; float p[4];
#pragma unroll
            for (int t = 0; t < 4; ++t) { const int dl = i - (16 * jt + 4 * q + t); const float f = dl >= 0 ? exp2f(l2f * (float)dl) : exp2f(l2b * (float)(-dl - 1)); p[t] = sc[jt][t] * f; }
            w[2 * half] = pack2(p[0], p[1]); w[2 * half + 1] = pack2(p[2], p[3]); }
        xp[s] = __builtin_bit_cast(bf16x8, w); }
    const float xif = exp2f(l2f * (float)(i + 1)), xib = exp2f(l2b * (float)(127 - i));
    f32x4 o[8]; float ss = 0.f;
#pragma unroll
    for (int et = 0; et < 8; ++et) { f32x4 a = (f32x4){0.f, 0.f, 0.f, 0.f}, tf = a, tb = a;
#pragma unroll
        for (int s = 0; s < 4; ++s) { const LAS unsigned short* vp = VT + (16 * et + r) * 136 + 32 * s + 4 * q;
            const u32x2 y0 = *(const LAS u32x2*)vp, y1 = *(const LAS u32x2*)(vp + 16); const u32x4 yw = (u32x4){y0.x, y0.y, y1.x, y1.y};
            a = mma(__builtin_bit_cast(bf16x8, yw), xp[s], a);
            tf = mma(*(const LAS bf16x8*)(SfT + (16 * et + r) * 136 + 32 * s + 8 * q), xq[s], tf);
            tb = mma(*(const LAS bf16x8*)(SbT + (16 * et + r) * 136 + 32 * s + 8 * q), xq[s], tb); }
        a = a + tf * xif + tb * xib; o[et] = a; ss += a[0] * a[0] + a[1] * a[1] + a[2] * a[2] + a[3] * a[3]; }
    ss += xor_lane<16>(ss); ss += xor_lane<32>(ss);
    const float rinv = rsqrtf(ss * (1.0f / 128.0f) + EPS);
#pragma unroll
    for (int et = 0; et < 8; ++et) { const u32x2 gw = *(const u32x2*)(Gb + grow * 512 + h * 128 + 16 * et + 4 * q);
        u32x2 w; w.x = pack2(silu_f(bflo(gw.x)) * o[et][0] * rinv, silu_f(bfhi(gw.x)) * o[et][1] * rinv); w.y = pack2(silu_f(bflo(gw.y)) * o[et][2] * rinv, silu_f(bfhi(gw.y)) * o[et][3] * rinv);
        *(u32x2*)(MIX + grow * D + h * 128 + 16 * et + 4 * q) = w; }
    if (cnt) publish_block(cnt); else __syncthreads();
}
DI void ph_ret_out(const Params& P, ldsp lds, int j, bool with_ctx, unsigned* cnt  ) {
    if (cnt) {
        const int c = (int)blockIdx.x;
        for (int k = 0;; ++k) { int u; if (c < 240) { u = c + 240 * k; if (u >= 528) break; } else { if (k) break; u = 528 + (c - 240); }
            if (u < 32) ret_out_unit(P, lds, j, u >> 1, u & 1, cnt); else ret_out_unit(P, lds, j, (u - 32) >> 5, 2 + ((u - 32) & 31), nullptr); }
        return;
    }
    const int nper = with_ctx ? 34 : 32, n = 16 * nper;
    for (int u = blockIdx.x; u < n; u += gridDim.x) { const int bh = u / nper, chunk = u % nper + (with_ctx ? 0 : 2); ret_out_unit(P, lds, j, bh, chunk, nullptr); }
}

DI void sg_unit(const Params& P, ldsp lds, int j, int chunk, int g, unsigned* cnt) {
    const int tid = opaque_tid(), lane = tid & 63, wv = tid >> 6, r = lane & 15, q = lane >> 4, row0 = chunk * 128;
    const bf16_t* Z = (const bf16_t*)(P.ws + WS_P + SZ_HALF); bf16_t* MIX = (bf16_t*)(P.ws + WS_MIX);
    LAS f32x2* st = (LAS f32x2*)lds; LAS unsigned short* VnT = (LAS unsigned short*)(lds + 1024);
    { const int p = tid >> 2, part = tid & 3; const bf16_t* zp = Z + (size_t)(row0 + p) * 1024 + 512 + part * 128; float s1 = 0.f, s2 = 0.f;
#pragma unroll
      for (int i = 0; i < 16; ++i) { const u32x4 w = *(const u32x4*)(zp + 8 * i);
          const float f0 = bflo(w.x), f1 = bfhi(w.x), f2 = bflo(w.y), f3 = bfhi(w.y), f4 = bflo(w.z), f5 = bfhi(w.z), f6 = bflo(w.w), f7 = bfhi(w.w);
          s1 += ((f0 + f1) + (f2 + f3)) + ((f4 + f5) + (f6 + f7)); s2 += ((f0 * f0 + f1 * f1) + (f2 * f2 + f3 * f3)) + ((f4 * f4 + f5 * f5) + (f6 * f6 + f7 * f7)); }
      s1 += xor_lane<1>(s1); s1 += xor_lane<2>(s1); s2 += xor_lane<1>(s2); s2 += xor_lane<2>(s2);
      const float mean = s1 * (1.0f / 512.0f); float var = s2 * (1.0f / 512.0f) - mean * mean; var = var > 0.f ? var : 0.f;
      if (part == 0) st[p] = (f32x2){mean, rsqrtf(var + EPS)}; }
    __syncthreads();
    { const int p = tid & 127, cq = tid >> 7; const f32x2 s = st[p];
#pragma unroll
      for (int c4 = 0; c4 < 4; ++c4) { const int c0 = (cq * 4 + c4) * 8, ch = g * 128 + c0; const u32x4 w = *(const u32x4*)(Z + (size_t)(row0 + p) * 1024 + 512 + ch);
          const f32x4 lw0 = *(const f32x4*)(P.sg_ln_w + j * 512 + ch), lw1 = *(const f32x4*)(P.sg_ln_w + j * 512 + ch + 4), lb0 = *(const f32x4*)(P.sg_ln_b + j * 512 + ch), lb1 = *(const f32x4*)(P.sg_ln_b + j * 512 + ch + 4);
#pragma unroll
          for (int e = 0; e < 8; ++e) { const unsigned ww = w[e >> 1]; const float vf = (e & 1) ? bfhi(ww) : bflo(ww); const float lwv = e < 4 ? lw0[e & 3] : lw1[e & 3], lbv = e < 4 ? lb0[e & 3] : lb1[e & 3];
              VnT[(c0 + e) * 136 + p] = f2bf((vf - s.x) * s.y * lwv + lbv); } } }
    const bf16_t* W = (const bf16_t*)(P.ws + WS_SGW) + (size_t)(j * 4 + g) * 16384; const int qq = 16 * wv + r;
    bf16x8 xw[4];
#pragma unroll
    for (int s = 0; s < 4; ++s) xw[s] = *(const bf16x8*)(W + qq * 128 + 32 * s + 8 * q);
    __syncthreads();
    const float bias = P.sg_b[(j * 4 + g) * 128 + qq];
#pragma unroll
    for (int ct = 0; ct < 8; ++ct) { f32x4 a = (f32x4){0.f, 0.f, 0.f, 0.f};
#pragma unroll
        for (int s = 0; s < 4; ++s) a = mma(*(const LAS bf16x8*)(VnT + (16 * ct + r) * 136 + 32 * s + 8 * q), xw[s], a);
        const size_t go = (size_t)(row0 + qq) * 1024 + g * 128 + 16 * ct + 4 * q; const u32x2 uw = *(const u32x2*)(Z + go);
        u32x2 w; w.x = pack2(bflo(uw.x) * (a[0] + bias), bfhi(uw.x) * (a[1] + bias)); w.y = pack2(bflo(uw.y) * (a[2] + bias), bfhi(uw.y) * (a[3] + bias));
        *(u32x2*)(MIX + go + 512) = w; }
    if (cnt) publish_block(cnt); else __syncthreads();
}
template <int W> DI void pool_frag(const LAS unsigned short* T, int lr, int q, float inv, bf16x8 (&xm)[4]) {
    constexpr int left = W / 2;
#pragma unroll
    for (int s = 0; s < 4; ++s) { const LAS unsigned short* base = T + (lr + 8 - left) * 136 + 32 * s + 8 * q;
        float acc[8];
#pragma unroll
        for (int e = 0; e < 8; ++e) acc[e] = 0.f;
#pragma unroll
        for (int i = 0; i < W; ++i) { const u32x4 v = *(const LAS u32x4*)(base + i * 136);
            acc[0] += bflo(v.x); acc[1] += bfhi(v.x); acc[2] += bflo(v.y); acc[3] += bfhi(v.y); acc[4] += bflo(v.z); acc[5] += bfhi(v.z); acc[6] += bflo(v.w); acc[7] += bfhi(v.w); }
        const u32x4 t = *(const LAS u32x4*)(base + left * 136); u32x4 o;
        o.x = pack2(acc[0] * inv - bflo(t.x), acc[1] * inv - bfhi(t.x)); o.y = pack2(acc[2] * inv - bflo(t.y), acc[3] * inv - bfhi(t.y));
        o.z = pack2(acc[4] * inv - bflo(t.z), acc[5] * inv - bfhi(t.z)); o.w = pack2(acc[6] * inv - bflo(t.w), acc[7] * inv - bfhi(t.w));
        xm[s] = __builtin_bit_cast(bf16x8, o); }
}
DI void pool_unit(const Params& P, ldsp lds, int j, int chunk, int g, unsigned* cnt) {
    const int tid = opaque_tid(), lane = tid & 63, wv = tid >> 6, r = lane & 15, q = lane >> 4, row0 = chunk * 128;
    const bf16_t* PC = (const bf16_t*)(P.ws + WS_P); bf16_t* MIX = (bf16_t*)(P.ws + WS_MIX);
    int s0, len; if (row0 < NLAT) { s0 = row0 & ~4095; len = 4096; } else { s0 = NLAT + ((row0 - NLAT) & ~255); len = 256; }
    LAS unsigned short* T = (LAS unsigned short*)lds;
#pragma unroll
    for (int it = 0; it < 5; ++it) { const int idx = tid + 512 * it; if (idx < 144 * 16) { const int lrow = idx >> 4, ch = idx & 15, rr = row0 - 8 + lrow;
        u32x4 v = (u32x4){0u, 0u, 0u, 0u}; if (rr >= s0 && rr < s0 + len) v = *(const u32x4*)(PC + (size_t)rr * 512 + g * 128 + ch * 8);
        *(LAS u32x4*)(T + lrow * 136 + ch * 8) = v; } }
    LAS unsigned short* Wl = T + 144 * 136;
    { const bf16_t* Wg = (const bf16_t*)(P.ws + WS_PWT) + (size_t)(j * 4 + g) * 16384;
#pragma unroll
      for (int it = 0; it < 4; ++it) { const int idx = tid + 512 * it, dd = idx >> 4, ch = idx & 15; *(LAS u32x4*)(Wl + dd * 136 + ch * 8) = *(const u32x4*)(Wg + dd * 128 + ch * 8); } }
    __syncthreads();
    const int lr = 16 * wv + r, row = row0 + lr, w = 2 << g, left = w >> 1, right = w - 1 - left;
    int lo = row - left, hi = row + right; if (lo < s0) lo = s0; if (hi > s0 + len - 1) hi = s0 + len - 1;
    const float inv = 1.0f / (float)(hi - lo + 1);
    bf16x8 xm[4];
    if (g == 0) pool_frag<2>(T, lr, q, inv, xm); else if (g == 1) pool_frag<4>(T, lr, q, inv, xm);
    else if (g == 2) pool_frag<8>(T, lr, q, inv, xm); else pool_frag<16>(T, lr, q, inv, xm);
#pragma unroll
    for (int dt = 0; dt < 8; ++dt) { f32x4 a = (f32x4){0.f, 0.f, 0.f, 0.f};
#pragma unroll
        for (int s = 0; s < 4; ++s) a = mma(*(const LAS bf16x8*)(Wl + (16 * dt + r) * 136 + 32 * s + 8 * q), xm[s], a);
        const int dc = g * 128 + 16 * dt + 4 * q; const f32x4 ps = *(const f32x4*)(P.pool_scale + j * 512 + dc);
        u32x2 o; o.x = pack2(a[0] * ps[0], a[1] * ps[1]); o.y = pack2(a[2] * ps[2], a[3] * ps[3]);
        *(u32x2*)(MIX + (size_t)row * D + dc) = o; }
    if (cnt) publish_block(cnt); else __syncthreads();
}
DI void ph_oddmix(const Params& P, ldsp lds, int j, int nchunks, unsigned* cnt  ) {
    const int G = gridDim.x, n = nchunks * 4;
    if (cnt) {
        const int c = (int)blockIdx.x;
        for (int k = 0;; ++k) { int u; if (c < 240) { u = c + 240 * k; if (u >= 528) break; } else { if (k) break; u = 528 + (c - 240); }
            if (u < 32) sg_unit(P, lds, j, 128 + (u & 7), u >> 3, cnt); else sg_unit(P, lds, j, (u - 32) & 127, (u - 32) >> 7, nullptr); }
        for (int k = 0;; ++k) { int u; if (c < 240) { u = (239 - c) + 240 * k; if (u >= 528) break; } else { if (k) break; u = 528 + (c - 240); }
            if (u < 32) pool_unit(P, lds, j, 128 + (u & 7), u >> 3, cnt); else pool_unit(P, lds, j, (u - 32) & 127, (u - 32) >> 7, nullptr); }
        return;
    }
    for (int u = blockIdx.x; u < n; u += G) sg_unit(P, lds, j, u % nchunks, u / nchunks, nullptr);
    for (int u = G - 1 - (int)blockIdx.x; u < n; u += G) pool_unit(P, lds, j, u % nchunks, u / nchunks, nullptr);
}
DI void ph_final(const Params& P) {
    const int tid = opaque_tid(), lane = tid & 63, wv = tid >> 6; const float* xr = (const float*)(P.ws + WS_XR);
    f32x4 fw[4];
#pragma unroll
    for (int j = 0; j < 4; ++j) fw[j] = *(const f32x4*)(P.final_w + (j * 64 + lane) * 4);
    for (int row = (blockIdx.x * 8 + wv) * 2; row < NLAT; row += gridDim.x * 16) {
        f32x4 v[2][4]; float ss[2] = {0.f, 0.f};
#pragma unroll
        for (int rr = 0; rr < 2; ++rr)
#pragma unroll
            for (int j = 0; j < 4; ++j) v[rr][j] = ((const f32x4*)(xr + (size_t)(row + rr) * D))[j * 64 + lane];
#pragma unroll
        for (int rr = 0; rr < 2; ++rr) {
#pragma unroll
            for (int j = 0; j < 4; ++j) ss[rr] += v[rr][j][0] * v[rr][j][0] + v[rr][j][1] * v[rr][j][1] + v[rr][j][2] * v[rr][j][2] + v[rr][j][3] * v[rr][j][3];
            ss[rr] = wave_sum(ss[rr]); const float rstd = rsqrtf(ss[rr] * (1.0f / 1024.0f) + EPS);
#pragma unroll
            for (int j = 0; j < 4; ++j) *(f32x4*)(P.out + (size_t)(row + rr) * D + (j * 64 + lane) * 4) = v[rr][j] * rstd * fw[j]; }
    }
}

__global__ void __launch_bounds__(512) mega(Params P) {
    extern __shared__ __attribute__((aligned(16))) unsigned char smem[];
    ldsp lds = (ldsp)smem;
    cg::grid_group grid = cg::this_grid();
    unsigned char* ws = P.ws; unsigned char* wb = ws + WS_WB;
    bf16_t* H = (bf16_t*)(ws + WS_H); bf16_t* MIX = (bf16_t*)(ws + WS_MIX); bf16_t* ACT = (bf16_t*)(ws + WS_P); float* XR = (float*)(ws + WS_XR);
    const float* mod = (const float*)(ws + WS_MOD); const float* wmt = (const float*)(ws + WS_WM); float* rss = (float*)(ws + WS_RSS);
    const float* bin = (const float*)(ws + WS_BIN); const float* bgu = (const float*)(ws + WS_BGU);
    if (blockIdx.x == 0) for (int k = threadIdx.x; k < XCD_BAR_WORDS; k += 512) __hip_atomic_store((unsigned*)(ws + WS_BAR) + k, 0u, __ATOMIC_RELAXED, __HIP_MEMORY_SCOPE_AGENT);
    for (int k = blockIdx.x * 512 + threadIdx.x; k < (int)((WS_ZEND - WS_ZERO) / 4) + CNT_WORDS; k += gridDim.x * 512) __hip_atomic_store((unsigned*)(ws + WS_ZERO) + k, 0u, __ATOMIC_RELAXED, __HIP_MEMORY_SCOPE_AGENT);
    if (threadIdx.x < 4) ((LAS unsigned*)(lds + LDS_WORK))[threadIdx.x] = 0u;
    ph_init(P, lds); grid.sync();
    const XcdBarrier bar = xcd_barrier_post((unsigned*)(ws + WS_BAR), (volatile LAS unsigned*)(lds + LDS_WORK));
#define GSYNC() xcd_barrier(bar)
    ph_norm0(P); convert_inout(P, lds, 0); GSYNC();
#pragma unroll 1
    for (int i = 0; i < 4; ++i) {
        const int j = i >> 1; const bool even = !(i & 1);
        const int M1 = i <= 2 ? MTOT : NLAT, M2 = i <= 1 ? MTOT : NLAT;
        const float* rss1 = rss + (size_t)(i * 2 + 0) * MTOT; float* rss2 = rss + (size_t)(i * 2 + 1) * MTOT; float* rss1n = rss + (size_t)(i * 2 + 2) * MTOT;
        const bool ho = (M2 == MTOT) && gridDim.x == 256;
        unsigned* cnt2 = (unsigned*)(ws + WS_CNT) + (8 + i) * 16;
        const EpiRes Eout{i == 0 ? P.x : XR, i == 0 ? P.ctx : XR + (size_t)NLAT * D, XR, mod + (size_t)i * 5 * 6144 + 2 * 1024, H, wmt + (size_t)(i * 2 + 1) * 5 * 1024, rss2, lds};
#define g2c_tail() do { if (blockIdx.x >= 240) { wait_count(cnt2, even ? 32u : 64u); \
            pg8::Gemm g{MIX, (const bf16_t*)(wb + WB_OUT), MTOT, 1024, 1024}; OneUnitOrder S{64 + ((int)blockIdx.x - 240) / 4, ((int)blockIdx.x - 240) % 4}; \
            pg8::gemm_phase<EpiRes, OneUnitOrder, false>(lds, g, S, Eout, nullptr); } } while (0)
        if (even) {
            EpiEvenIn E{(bf16_t*)(ws + WS_P), (bf16_t*)(ws + WS_P + SZ_HALF), (bf16_t*)(ws + WS_P + 2 * SZ_HALF), (bf16_t*)(ws + WS_P + 3 * SZ_HALF), (bf16_t*)(ws + WS_P + 4 * SZ_HALF), (const float*)(ws + WS_ROPE), rss1, bin + (size_t)i * 5 * 3072, lds};
            if (gridDim.x == 256 && M1 == MTOT) {
                run_gemm(lds, H, (const bf16_t*)(wb + WB_IN), NLAT, 3072, 1024, E); GSYNC();
                ph_ret_kv_conv_ho(P, lds, j, i, i == 0 ? 48 : 16, M2 == MTOT, E, (unsigned*)(ws + WS_CNT) + (i * 2 + 1) * 16); GSYNC();
                ph_scan(P, j); GSYNC();
                ph_ret_out(P, lds, j, M2 == MTOT, ho ? cnt2 : nullptr); if (ho) { g2c_tail(); convert_ffn_w(P, lds, i, (int)blockIdx.x - 48, 192); } else convert_ffn(P, lds, i, M2 == MTOT ? 544 : 512); GSYNC();
            } else {
                run_gemm(lds, H, (const bf16_t*)(wb + WB_IN), M1, 3072, 1024, E); convert_ffn(P, lds, i, (M1 / 256) * 12); GSYNC();
                ph_ret_kv_conv(P, lds, j, M2 / 32); GSYNC();
                ph_scan(P, j); GSYNC();
                ph_ret_out(P, lds, j, M2 == MTOT, nullptr); GSYNC();
            }
        } else {
            EpiOddIn E{(bf16_t*)(ws + WS_P), (bf16_t*)(ws + WS_P + SZ_HALF), rss1, bin + (size_t)i * 5 * 3072, lds};
            run_gemm(lds, H, (const bf16_t*)(wb + WB_IN), M1, 1536, 1024, E); convert_ffn(P, lds, i, (M1 / 256) * 6); GSYNC();
            ph_oddmix(P, lds, j, M2 / 128, ho ? cnt2 : nullptr); if (ho) g2c_tail(); GSYNC();
        }
        run_gemm(lds, MIX, (const bf16_t*)(wb + WB_OUT), ho ? NLAT : M2, 1024, 1024, Eout); GSYNC();
        const EpiRes Edn{XR, XR + (size_t)NLAT * D, XR, mod + (size_t)i * 5 * 6144 + 5 * 1024, i < 3 ? H : nullptr, wmt + (size_t)(i < 3 ? (i * 2 + 2) : 0) * 5 * 1024, rss1n, lds};
        const EpiGU Egu{ACT, rss2, bgu + (size_t)i * 5 * 5632, lds};
        const bool handoff = ho;
        if (handoff) {
            unsigned* cnt = (unsigned*)(ws + WS_CNT) + (i * 2 + 0) * 16;
            { pg8::Gemm g{H, (const bf16_t*)(wb + WB_GU), MTOT, 5632, 1024}; CtxFirstOrder S; S.nN = 22; S.c = (int)blockIdx.x; S.nctx = 88; S.ntot = 1496; S.spec = 56; S.cnt = cnt;
              pg8::gemm_phase<EpiGU, CtxFirstOrder, false>(lds, g, S, Egu, nullptr); }
            if (blockIdx.x >= 240) { wait_count(cnt, 8u * 88u);
                pg8::Gemm g{ACT, (const bf16_t*)(wb + WB_DN), MTOT, 1024, 2816}; OneUnitOrder S{64 + ((int)blockIdx.x - 240) / 4, ((int)blockIdx.x - 240) % 4};
                pg8::gemm_phase<EpiRes, OneUnitOrder, false>(lds, g, S, Edn, nullptr); }
            GSYNC();
            run_gemm(lds, ACT, (const bf16_t*)(wb + WB_DN), NLAT, 1024, 2816, Edn);
        } else {
            run_gemm(lds, H, (const bf16_t*)(wb + WB_GU), M2, 5632, 1024, Egu); GSYNC();
            run_gemm(lds, ACT, (const bf16_t*)(wb + WB_DN), M2, 1024, 2816, Edn);
        }
        if (i < 3) convert_inout(P, lds, i + 1);
        GSYNC();
    }
    ph_final(P);
}
}

extern "C" void kernel_launch(void* const* d_in, const int* in_sizes, int n_in, void* d_out, int out_size, void* d_ws, size_t ws_size, hipStream_t stream) {
    static int grid = 0;
    if (grid == 0) {
        if (n_in != 25 || ws_size < mk::WS_END) { fprintf(stderr, "kernel_launch: need 25 inputs and %zu bytes of workspace (got %d, %zu)\n", (size_t)mk::WS_END, n_in, ws_size); grid = -1; return; }
        int dev = 0, cus = 0, per_cu = 0;
        hipGetDevice(&dev); hipDeviceGetAttribute(&cus, hipDeviceAttributeMultiprocessorCount, dev);
        if (hipFuncSetAttribute((const void*)mk::mega, hipFuncAttributeMaxDynamicSharedMemorySize, mk::LDS_BYTES) != hipSuccess) { fprintf(stderr, "kernel_launch: hipFuncSetAttribute failed\n"); grid = -1; return; }
        if (hipOccupancyMaxActiveBlocksPerMultiprocessor(&per_cu, (const void*)mk::mega, 512, mk::LDS_BYTES) != hipSuccess || per_cu < 1) { fprintf(stderr, "kernel_launch: occupancy query failed (%d)\n", per_cu); grid = -1; return; }
        grid = cus * (per_cu > 1 ? 1 : per_cu);
    }
    if (grid < 0) return;
    mk::Params p{};
    const float** pp = (const float**)&p;
    for (int i = 0; i < 25; ++i) pp[i] = (const float*)d_in[i];
    p.out = (float*)d_out; p.ws = (unsigned char*)d_ws;
    void* args[] = {&p};
    hipError_t e = hipLaunchCooperativeKernel((const void*)mk::mega, dim3(grid), dim3(512), args, mk::LDS_BYTES, stream);
    if (e != hipSuccess) fprintf(stderr, "cooperative launch failed: %s (grid %d)\n", hipGetErrorString(e), grid);
}
```

```cpp
#include <hip/hip_runtime.h>
#include <hip/hip_cooperative_groups.h>
#include <cstdio>
namespace cg = cooperative_groups;
#define LAS __attribute__((address_space(3)))
#define XB_TMO      128
#define XB_XCNT(j)  (256  + 64 * (j))
#define XB_XSUB(j)  (1280 + 64 * (j))
#define XB_XGEN(j)  (2304 + 64 * (j))
#define XB_TOP      3328
#define XB_TOPGEN   3392
#define XCD_BAR_WORDS 3456
#define XB_SPIN_CAP (1u << 18)

__device__ __forceinline__ unsigned xb_ld(unsigned* p)              { return __hip_atomic_load(p, __ATOMIC_RELAXED, __HIP_MEMORY_SCOPE_AGENT); }
__device__ __forceinline__ unsigned xb_add(unsigned* p, unsigned v) { return __hip_atomic_fetch_add(p, v, __ATOMIC_RELAXED, __HIP_MEMORY_SCOPE_AGENT); }
__device__ __forceinline__ unsigned xb_xcc_id() { return (unsigned)__builtin_amdgcn_s_getreg((3 << 11) | 20) & 0xFu; }
#define XB_SPIN(cond, bar) do { unsigned _sp = 0; while (cond) { __builtin_amdgcn_s_sleep(1); \
    if ((++_sp & 255u) == 0u) { if (xb_ld(&(bar)[XB_TMO])) break; if (_sp > XB_SPIN_CAP) { atomicAdd(&(bar)[XB_TMO], 1u); break; } } } } while (0)

struct XcdBarrier {
    unsigned* bar; unsigned x;
    volatile LAS unsigned* st;
};

__device__ __forceinline__ XcdBarrier xcd_barrier_post(unsigned* bar, volatile LAS unsigned* st) {
    XcdBarrier b; b.bar = bar; b.x = xb_xcc_id(); b.st = st;
    if (threadIdx.x == 0) (void)xb_add(&bar[XB_XCNT(b.x)], 1u);
    return b;
}
__device__ __forceinline__ void xcd_barrier_complete(unsigned* bar, unsigned x, unsigned& nloc, unsigned& nx) {
    const unsigned G = gridDim.x * gridDim.y * gridDim.z;
    unsigned sum, cnt, mine, sp = 0u;
    for (;;) {
        sum = 0u; cnt = 0u; mine = 0u;
#pragma unroll
        for (unsigned j = 0; j < 16; ++j) { const unsigned c = xb_ld(&bar[XB_XCNT(j)]); sum += c; cnt += (c > 0u) ? 1u : 0u; mine = (j == x) ? c : mine; }
        if (sum == G) break;
        __builtin_amdgcn_s_sleep(1);
        if ((++sp & 255u) == 0u) { if (xb_ld(&bar[XB_TMO])) break; if (sp > XB_SPIN_CAP) { atomicAdd(&bar[XB_TMO], 1u); break; } }
    }
    nloc = mine > 0u ? mine : 1u; nx = cnt > 0u ? cnt : 1u;
}

__device__ __forceinline__ void xcd_barrier(const XcdBarrier& b) {
    asm volatile("s_waitcnt vmcnt(0)" ::: "memory");
    __syncthreads();
    if (threadIdx.x == 0) {
        unsigned* bar = b.bar;
        __builtin_amdgcn_s_waitcnt(0);
        unsigned nloc = b.st[0], nx = b.st[1];
        if (nloc == 0u) { xcd_barrier_complete(bar, b.x, nloc, nx); b.st[0] = nloc; b.st[1] = nx; }
        const unsigned old = xb_add(&bar[XB_XSUB(b.x)], 1u);
        const unsigned gen = old / nloc;
        if (old + 1u == (gen + 1u) * nloc) {
            __builtin_amdgcn_fence(__ATOMIC_RELEASE, "agent");
            asm volatile("s_waitcnt vmcnt(0)" ::: "memory");
            const unsigned og = xb_add(&bar[XB_TOP], 1u);
            const unsigned tg = og / nx;
            if (og + 1u == (tg + 1u) * nx) xb_add(&bar[XB_TOPGEN], 1u);
            else XB_SPIN(xb_ld(&bar[XB_TOPGEN]) == tg, bar);
            __builtin_amdgcn_fence(__ATOMIC_ACQUIRE, "agent");
            xb_add(&bar[XB_XGEN(b.x)], 1u);
            asm volatile("s_waitcnt vmcnt(0)" ::: "memory");
        } else {
            XB_SPIN(xb_ld(&bar[XB_XGEN(b.x)]) == gen, bar);
            __builtin_amdgcn_fence(__ATOMIC_ACQUIRE, "agent");
            asm volatile("s_waitcnt vmcnt(0)" ::: "memory");
        }
    }
    __syncthreads();
}
namespace pg8 {
#define PG8_LAS __attribute__((address_space(3)))
typedef unsigned short bf16_t;
typedef short bf16x8 __attribute__((ext_vector_type(8)));
typedef float f32x4 __attribute__((ext_vector_type(4)));
typedef unsigned u32x4 __attribute__((ext_vector_type(4)));
constexpr int BM = 256, BK = 64, HALF = 128, HTB = HALF * BK * 2  , STAGE_BYTES = 8 * HTB, NXCD = 8, WGM = 8;

__host__ __device__ __forceinline__ int lds_byte(int r, int c) { const int st = (r >> 4) * 2 + (c >> 5), rr = r & 15, cc = c & 31, ob = rr * 64 + cc * 2; return st * 1024 + (ob ^ (((ob >> 9) & 1) << 5)); }
__host__ __device__ __forceinline__ void stage_rc(int b, int& R, int& C) { const int st = b / 1024, sb = b % 1024, swz = sb ^ (((sb >> 9) & 1) << 5); R = (st >> 1) * 16 + swz / 64; C = (st & 1) * 32 + (swz % 64) / 2; }
__host__ __device__ __forceinline__ int perm32(int rho) { const int n = rho >> 4, i = rho & 15; return 8 * (i >> 2) + 4 * n + (i & 3); }

struct Unit { int pm, pn; };
struct Gemm { const bf16_t* A; const bf16_t* Bt; int M, N, K; };

struct StaticOrder {
    int nM, nN, nwg, G, c;
    __host__ __device__ void init(int M, int N, int G_, int c_) { nM = M / BM; nN = N / BM; nwg = nM * nN; G = G_; c = c_; }
    __host__ __device__ bool next(int i, Unit& u) const {
        const long L = (long)i * G + c; if (L >= nwg) return false;
        int wgid = (int)L; { const int q = nwg / NXCD, r = nwg % NXCD, xcd = wgid % NXCD, off = wgid / NXCD; wgid = (xcd < r ? xcd * (q + 1) : r * (q + 1) + (xcd - r) * q) + off; }
        const int nig = WGM * nN, gid = wgid / nig, fm = gid * WGM, gsz = (nM - fm) < WGM ? (nM - fm) : WGM;
        u.pm = fm + ((wgid % nig) % gsz); u.pn = (wgid % nig) / gsz; return true;
    }
    __device__ __forceinline__ void a_ready(const Unit&) const {}
    __device__ __forceinline__ void done(const Unit&) const {}
};
__device__ __forceinline__ unsigned cvt_pk_bf16(float lo, float hi) { unsigned r; asm volatile("v_cvt_pk_bf16_f32 %0, %1, %2" : "=v"(r) : "v"(lo), "v"(hi)); return r; }
typedef float f32x2 __attribute__((ext_vector_type(2)));
__device__ __forceinline__ f32x2 gelu_pk(f32x2 v) {
    const f32x2 av = __builtin_elementwise_abs(v), d = av * 0.2316418882f + 1.0f;
    f32x2 t; t.x = __builtin_amdgcn_rcpf(d.x); t.y = __builtin_amdgcn_rcpf(d.y);
    f32x2 q = t * 0.5307027145f + (-0.7265760135f); q = q * t + 0.7107068705f; q = q * t + (-0.142248368f); q = q * t + 0.127414796f; q = q * t;
    const f32x2 s = (v * v) * (-0.72134752044f);
    f32x2 e; e.x = __builtin_amdgcn_exp2f(s.x); e.y = __builtin_amdgcn_exp2f(s.y);
    const f32x2 m = v * (q * e), r = v - m;
    f32x2 o; o.x = v.x < 0.f ? m.x : r.x; o.y = v.y < 0.f ? m.y : r.y; return o;
}

template <class Epi, class Sched, bool STAMP = false>
__device__ __forceinline__ void gemm_phase(PG8_LAS unsigned char* lds, const Gemm g, const Sched& S, const Epi& E, unsigned long long* stamps) {
    int tid_ = threadIdx.x; asm volatile("" : "+v"(tid_)); const int tid = tid_, wid = __builtin_amdgcn_readfirstlane(tid >> 6), lane = tid & 63, wr = wid >> 2, wc = wid & 3, fr = lane & 15, fq = lane >> 4;
    const int K = g.K, nt = K / BK;
    int ts_lo = 0, ts_hi = 0, nts = 0; const unsigned long long rt_entry = STAMP ? (unsigned long long)wall_clock64() : 0ull;
#define PG8_STAMP() do { if (STAMP && wid == 0 && nts < 64) { const unsigned long long _c = (unsigned long long)clock64(); \
        ts_lo = (lane == nts) ? (int)(unsigned)_c : ts_lo; ts_hi = (lane == nts) ? (int)(unsigned)(_c >> 32) : ts_hi; ++nts; } } while (0)
    PG8_STAMP();
    unsigned voffA[2], voffB[2];
#pragma unroll
    for (int i = 0; i < 2; ++i) { int R, C; stage_rc(tid * 16 + i * 8192, R, C); const int Rb = Epi::PERM ? ((R & ~31) + perm32(R & 31)) : R;
        voffA[i] = (unsigned)(R * K + C) * 2u; voffB[i] = (unsigned)(Rb * K + C) * 2u; }
    const size_t kstep = (size_t)(BK * 2);
    const size_t hstep = (size_t)HALF * K * 2;
    const size_t tstep = 2 * hstep;
    const unsigned ldsw = (unsigned)wid * 1024u;
    const int aoff = lds_byte(wr * 64 + fr, fq * 8), boff = lds_byte(wc * 32 + fr, fq * 8);
#define PG8_SA(b, h) (((b) * 2 + (h)) * HTB)
#define PG8_SB(b, h) ((4 + (b) * 2 + (h)) * HTB)
#define PG8_STAGE(bufoff, gbase, voff) do { _Pragma("unroll") for (int _i = 0; _i < 2; ++_i) \
        __builtin_amdgcn_global_load_lds((const unsigned*)((const char*)(gbase) + (voff)[_i]), (PG8_LAS unsigned*)(lds + (bufoff) + ldsw + _i * 8192), 16, 0, 0); } while (0)
#define PG8_LDA(dst, b, h) do { _Pragma("unroll") for (int m = 0; m < 4; ++m) _Pragma("unroll") for (int k = 0; k < 2; ++k) dst[m][k] = *(const PG8_LAS bf16x8*)(lds + PG8_SA(b, h) + aoff + m * 2048 + k * 1024); } while (0)
#define PG8_LDB(dst, b, h) do { _Pragma("unroll") for (int n = 0; n < 2; ++n) _Pragma("unroll") for (int k = 0; k < 2; ++k) dst[n][k] = *(const PG8_LAS bf16x8*)(lds + PG8_SB(b, h) + boff + n * 2048 + k * 1024); } while (0)
#define PG8_MMA(ai, bj, At, Bt) do { __builtin_amdgcn_s_setprio(1); _Pragma("unroll") for (int m = 0; m < 4; ++m) _Pragma("unroll") for (int n = 0; n < 2; ++n) _Pragma("unroll") for (int k = 0; k < 2; ++k) \
        acc[ai][bj][m][n] = __builtin_amdgcn_mfma_f32_16x16x32_bf16(Bt[n][k], At[m][k], acc[ai][bj][m][n], 0, 0, 0); __builtin_amdgcn_s_setprio(0); } while (0)
#define PG8_WAIT_V(n) asm volatile("s_waitcnt vmcnt(" #n ")" ::: "memory")
#define PG8_WAIT_L(n) asm volatile("s_waitcnt lgkmcnt(" #n ")" ::: "memory")
#define PG8_BAR __builtin_amdgcn_s_barrier()
#define PG8_SCHED __builtin_amdgcn_sched_barrier(0)
    Unit cur, nxt; int ui = 0;
    if (!S.next(0, cur)) return;
    f32x4 acc[2][2][4][2];
#pragma unroll
    for (int a = 0; a < 2; ++a)
#pragma unroll
        for (int b = 0; b < 2; ++b)
#pragma unroll
            for (int m = 0; m < 4; ++m)
#pragma unroll
                for (int n = 0; n < 2; ++n) acc[a][b][m][n] = (f32x4){0.f, 0.f, 0.f, 0.f};
    bf16x8 At[4][2], B0[2][2], B1[2][2];
    const char* cA = (const char*)g.A + (size_t)cur.pm * tstep; const char* cB = (const char*)g.Bt + (size_t)cur.pn * tstep;
    S.a_ready(cur);
    PG8_STAGE(PG8_SB(0, 0), cB, voffB); PG8_STAGE(PG8_SA(0, 0), cA, voffA); PG8_STAGE(PG8_SB(0, 1), cB + hstep, voffB); PG8_STAGE(PG8_SA(0, 1), cA + hstep, voffA);
    if (wr == 1) PG8_BAR;
    PG8_WAIT_V(4); PG8_BAR;
    PG8_STAGE(PG8_SB(1, 0), cB + kstep, voffB); PG8_STAGE(PG8_SA(1, 0), cA + kstep, voffA); PG8_STAGE(PG8_SB(1, 1), cB + hstep + kstep, voffB);
    PG8_WAIT_V(6); PG8_BAR;
    PG8_STAMP();
    for (;;) {
        const bool has_next = S.next(ui + 1, nxt);
        const char* nA = has_next ? (const char*)g.A + (size_t)nxt.pm * tstep : cA; const char* nB = has_next ? (const char*)g.Bt + (size_t)nxt.pn * tstep : cB;
        for (int t = 0; t < nt; t += 2) {
            const bool last = (t == nt - 2);
            const char* a1 = cA + (size_t)(t + 1) * kstep;
            const char* a2 = last ? nA : cA + (size_t)(t + 2) * kstep; const char* b2 = last ? nB : cB + (size_t)(t + 2) * kstep;
            const char* a3 = a2 + kstep; const char* b3 = b2 + kstep;
            if (last && has_next) S.a_ready(nxt);
            if constexpr (Epi::STAGED) { if (last) E.stage(cur, lds, wid, lane); }
            PG8_LDB(B0, 0, 0); PG8_SCHED; PG8_LDA(At, 0, 0); PG8_STAGE(PG8_SA(1, 1), a1 + hstep, voffA);
            PG8_WAIT_L(8); PG8_BAR; PG8_WAIT_L(0); PG8_MMA(0, 0, At, B0); PG8_BAR; PG8_SCHED;
            PG8_LDB(B1, 0, 1); PG8_STAGE(PG8_SB(0, 0), b2, voffB);
            PG8_BAR; PG8_WAIT_L(0); PG8_MMA(0, 1, At, B1); PG8_BAR;
            PG8_LDA(At, 0, 1); PG8_STAGE(PG8_SA(0, 0), a2, voffA);
            PG8_BAR; PG8_WAIT_L(0); PG8_MMA(1, 0, At, B0); PG8_BAR; PG8_SCHED;
            PG8_STAGE(PG8_SB(0, 1), b2 + hstep, voffB);
            PG8_WAIT_V(6); PG8_BAR; PG8_MMA(1, 1, At, B1); PG8_BAR;
            PG8_LDB(B0, 1, 0); PG8_SCHED; PG8_LDA(At, 1, 0); PG8_STAGE(PG8_SA(0, 1), a2 + hstep, voffA);
            PG8_WAIT_L(8); PG8_BAR; PG8_WAIT_L(0); PG8_MMA(0, 0, At, B0); PG8_BAR; PG8_SCHED;
            PG8_LDB(B1, 1, 1); PG8_STAGE(PG8_SB(1, 0), b3, voffB);
            PG8_BAR; PG8_WAIT_L(0); PG8_MMA(0, 1, At, B1); PG8_BAR;
            PG8_LDA(At, 1, 1); PG8_STAGE(PG8_SA(1, 0), a3, voffA);
            PG8_BAR; PG8_WAIT_L(0); PG8_MMA(1, 0, At, B0); PG8_BAR; PG8_SCHED;
            PG8_STAGE(PG8_SB(1, 1), b3 + hstep, voffB);
            PG8_WAIT_V(6); PG8_BAR; PG8_MMA(1, 1, At, B1); PG8_BAR;
        }
        PG8_STAMP();
        if constexpr (!Epi::AFTER_DRAIN) { E(acc, cur, wr, wc, fr, fq); S.done(cur); }
        PG8_STAMP();
        if (!has_next) break;
#pragma unroll
        for (int a = 0; a < 2; ++a)
#pragma unroll
            for (int b = 0; b < 2; ++b)
#pragma unroll
                for (int m = 0; m < 4; ++m)
#pragma unroll
                    for (int n = 0; n < 2; ++n) acc[a][b][m][n] = (f32x4){0.f, 0.f, 0.f, 0.f};
        cur = nxt; cA = nA; cB = nB; ++ui;
    }
    PG8_WAIT_V(0);
    if (wr == 0) PG8_BAR;
    PG8_BAR;
    if constexpr (Epi::AFTER_DRAIN) { E.fused(acc, cur, wr, wc, fr, fq, lds, wid, lane); S.done(cur); }
    PG8_STAMP();
    if (STAMP && wid == 0) { stamps[lane] = lane < nts ? (((unsigned long long)(unsigned)ts_hi << 32) | (unsigned)ts_lo) : 0ull;
        if (lane == 62) stamps[62] = rt_entry; if (lane == 63) stamps[63] = (unsigned long long)wall_clock64(); }
#undef PG8_STAMP
#undef PG8_SA
#undef PG8_SB
#undef PG8_STAGE
#undef PG8_LDA
#undef PG8_LDB
#undef PG8_MMA
#undef PG8_WAIT_V
#undef PG8_WAIT_L
#undef PG8_BAR
#undef PG8_SCHED
}
}

namespace mk {
using pg8::bf16_t; using pg8::bf16x8; using pg8::f32x4; using pg8::u32x4; using pg8::f32x2; using pg8::Unit;
#define DI __device__ __forceinline__
typedef LAS unsigned char* ldsp;
typedef unsigned u32x2 __attribute__((ext_vector_type(2)));

constexpr int D = 1024, NLAT = 16384, MTOT = 17408, DFF = 2816;
constexpr float EPS = 1e-6f;
constexpr float LOG2E = 1.4426950408889634f;

constexpr size_t SZ_HALF = (size_t)MTOT * 512 * 2;
constexpr size_t WS_XR = 0;
constexpr size_t WS_H = WS_XR + (size_t)MTOT * D * 4;
constexpr size_t WS_P = WS_H + (size_t)MTOT * D * 2;
constexpr size_t WS_MIX = WS_P + 5 * SZ_HALF;
constexpr size_t WS_KV = WS_MIX + (size_t)MTOT * D * 2;
constexpr size_t WS_WB = WS_KV + (size_t)16 * 34 * 2 * 16384 * 4;
constexpr size_t WB_IN = 0, WB_OUT = (size_t)3072 * 1024 * 2, WB_GU = WB_OUT + (size_t)1024 * 1024 * 2, WB_DN = WB_GU + (size_t)5632 * 1024 * 2, WB_END = WB_DN + (size_t)1024 * 2816 * 2;
constexpr size_t WS_MOD = WS_WB + WB_END;
constexpr size_t WS_ROPE = WS_MOD + (size_t)4 * 5 * 6144 * 4;
constexpr size_t WS_SGW = WS_ROPE + (size_t)2 * 4352 * 64 * 4;
constexpr size_t WS_PWT = WS_SGW + (size_t)2 * 4 * 128 * 128 * 2;
constexpr size_t WS_BAR = WS_PWT + (size_t)2 * 4 * 128 * 128 * 2;
constexpr size_t WS_WM = WS_BAR + (size_t)XCD_BAR_WORDS * 4;
constexpr size_t WS_ZERO = WS_WM + (size_t)4 * 2 * 5 * 1024 * 4;
constexpr size_t WS_BIN = WS_ZERO;
constexpr size_t WS_BGU = WS_BIN + (size_t)4 * 5 * 3072 * 4;
constexpr size_t WS_RSS = WS_BGU + (size_t)4 * 5 * 5632 * 4;
constexpr size_t WS_ZEND = WS_RSS + (size_t)8 * MTOT * 4;
constexpr size_t WS_CNT = WS_ZEND;
constexpr int CNT_WORDS = 16 * 16;
constexpr size_t WS_END = WS_CNT + (size_t)CNT_WORDS * 4;
static_assert((size_t)MTOT * DFF * 2 <= WS_KV - WS_P, "ACT alias");
constexpr int LDS_WORK = 4 * 128 * 136 * 2;
constexpr int LDS_BYTES = LDS_WORK + 16;

struct Params {
    const float *x, *c, *ctx, *c_ctx, *ada_w, *ada_b, *norm_w, *even_w_in, *even_w_out, *ret_decay, *conv_w, *conv_ln_w, *conv_ln_b,
        *odd_w_in, *odd_w_out, *pool_w, *pool_scale, *sg_ln_w, *sg_ln_b, *sg_w, *sg_b, *ffn_gate, *ffn_up, *ffn_down, *final_w;
    float* out; unsigned char* ws;
};

DI int opaque_tid() { int t = threadIdx.x; asm volatile("" : "+v"(t)); return t; }
DI unsigned short f2bf(float f) { unsigned u = __float_as_uint(f); u += 0x7fffu + ((u >> 16) & 1u); return (unsigned short)(u >> 16); }
DI unsigned pack2(float lo, float hi) { return (unsigned)f2bf(lo) | ((unsigned)f2bf(hi) << 16); }
DI float bflo(unsigned u) { return __uint_as_float(u << 16); }
DI float bfhi(unsigned u) { return __uint_as_float(u & 0xffff0000u); }
DI float bf1(unsigned short u) { return __uint_as_float((unsigned)u << 16); }
DI float silu_f(float v) { return v * __builtin_amdgcn_rcpf(1.0f + __expf(-v)); }
DI float sigm_f(float v) { return __builtin_amdgcn_rcpf(1.0f + __expf(-v)); }
DI f32x4 mma(bf16x8 y, bf16x8 x, f32x4 c) { return __builtin_amdgcn_mfma_f32_16x16x32_bf16(y, x, c, 0, 0, 0); }
DI float log2_decay(const float* logit) { const float x = *logit; return -log1pf(expf(-x)) * LOG2E; }
template <int X> DI float xor_lane(float v) {
    if constexpr (X < 32) return __builtin_bit_cast(float, __builtin_amdgcn_ds_swizzle(__builtin_bit_cast(int, v), (X << 10) | 0x1f));
    else return __shfl_xor(v, 32);
}
DI float wave_sum(float v) { v += xor_lane<1>(v); v += xor_lane<2>(v); v += xor_lane<4>(v); v += xor_lane<8>(v); v += xor_lane<16>(v); v += xor_lane<32>(v); return v; }
DI int mod_set(int row) { return row < NLAT ? (row >> 12) : 4; }

struct EpiEvenIn {
    static constexpr bool PERM = true, AFTER_DRAIN = false;
    static constexpr bool STAGED = true;
    bf16_t *Q, *K, *V, *G, *U; const float* rope; const float* rss; const float* bias; ldsp ldsb;
    DI void stage(const Unit& u, ldsp lds, int wid, int lane) const {
        const float* src = wid < 4 ? rss + u.pm * 256 + wid * 64 + lane : bias + (size_t)(u.pm < 64 ? (u.pm >> 4) : 4) * 3072 + u.pn * 256 + (wid - 4) * 64 + lane;
        __builtin_amdgcn_global_load_lds((const unsigned*)src, (LAS unsigned*)(lds + pg8::STAGE_BYTES + wid * 256), 4, 0, 0);
    }
    DI void operator()(const f32x4 (&acc)[2][2][4][2], const Unit& u, int wr, int wc, int fr, int fq) const {
        const int row0 = u.pm * 256 + wr * 64 + fr, colb = u.pn * 256 + wc * 32 + 8 * fq, region = u.pn >> 1, r8 = wc * 32 + 8 * fq;
        const LAS float* sp = (const LAS float*)(ldsb + pg8::STAGE_BYTES); f32x4 bv[2][2];
#pragma unroll
        for (int bj = 0; bj < 2; ++bj) { bv[bj][0] = *(const LAS f32x4*)(sp + 256 + bj * 128 + r8); bv[bj][1] = *(const LAS f32x4*)(sp + 256 + bj * 128 + r8 + 4); }
#pragma unroll
        for (int ai = 0; ai < 2; ++ai)
#pragma unroll
            for (int m = 0; m < 4; ++m) {
                const int row = row0 + ai * 128 + m * 16; const float rs = rsqrtf(sp[ai * 128 + wr * 64 + m * 16 + fr] * (1.0f / 1024.0f) + EPS);
                const f32x4 a0 = acc[ai][0][m][0] * rs + bv[0][0], a1 = acc[ai][0][m][1] * rs + bv[0][1], b0 = acc[ai][1][m][0] * rs + bv[1][0], b1 = acc[ai][1][m][1] * rs + bv[1][1];
                if (region < 2) {
                    const int pi = row < NLAT ? (row & 4095) : 4096 + ((row - NLAT) & 255), head = (u.pn & 1) * 2 + (r8 >> 6), dd = r8 & 63;
                    const float* cp = rope + (size_t)pi * 64 + dd; const float* sp = cp + (size_t)4352 * 64;
                    const f32x4 c0 = *(const f32x4*)cp, c1 = *(const f32x4*)(cp + 4), s0 = *(const f32x4*)sp, s1 = *(const f32x4*)(sp + 4);
                    const float sc = region == 0 ? 0.08838834764831845f : 1.0f;
                    const f32x4 o10 = (a0 * c0 - b0 * s0) * sc, o11 = (a1 * c1 - b1 * s1) * sc, o20 = (a0 * s0 + b0 * c0) * sc, o21 = (a1 * s1 + b1 * c1) * sc;
                    bf16_t* dst = (region == 0 ? Q : K) + (size_t)row * 512 + head * 128 + dd;
                    u32x4 w1, w2; w1.x = pg8::cvt_pk_bf16(o10[0], o10[1]); w1.y = pg8::cvt_pk_bf16(o10[2], o10[3]); w1.z = pg8::cvt_pk_bf16(o11[0], o11[1]); w1.w = pg8::cvt_pk_bf16(o11[2], o11[3]);
                    w2.x = pg8::cvt_pk_bf16(o20[0], o20[1]); w2.y = pg8::cvt_pk_bf16(o20[2], o20[3]); w2.z = pg8::cvt_pk_bf16(o21[0], o21[1]); w2.w = pg8::cvt_pk_bf16(o21[2], o21[3]);
                    *(u32x4*)dst = w1; *(u32x4*)(dst + 64) = w2;
                } else if (region < 4) {
                    bf16_t* dst = (region == 2 ? V : G) + (size_t)row * 512 + (colb & 511);
                    u32x4 w; w.x = pg8::cvt_pk_bf16(a0[0], a0[1]); w.y = pg8::cvt_pk_bf16(a0[2], a0[3]); w.z = pg8::cvt_pk_bf16(a1[0], a1[1]); w.w = pg8::cvt_pk_bf16(a1[2], a1[3]);
                    *(u32x4*)dst = w;
                    w.x = pg8::cvt_pk_bf16(b0[0], b0[1]); w.y = pg8::cvt_pk_bf16(b0[2], b0[3]); w.z = pg8::cvt_pk_bf16(b1[0], b1[1]); w.w = pg8::cvt_pk_bf16(b1[2], b1[3]);
                    *(u32x4*)(dst + 128) = w;
                } else {
                    u32x4 w; w.x = pg8::cvt_pk_bf16(a0[0] * sigm_f(b0[0]), a0[1] * sigm_f(b0[1])); w.y = pg8::cvt_pk_bf16(a0[2] * sigm_f(b0[2]), a0[3] * sigm_f(b0[3]));
                    w.z = pg8::cvt_pk_bf16(a1[0] * sigm_f(b1[0]), a1[1] * sigm_f(b1[1])); w.w = pg8::cvt_pk_bf16(a1[2] * sigm_f(b1[2]), a1[3] * sigm_f(b1[3]));
                    *(u32x4*)(U + (size_t)row * 512 + (u.pn - 8) * 128 + r8) = w;
                }
            }
    }
};
struct EpiOddIn {
    static constexpr bool PERM = true, AFTER_DRAIN = false;
    static constexpr bool STAGED = true;
    bf16_t *PC, *Z; const float* rss; const float* bias; ldsp ldsb;
    DI void stage(const Unit& u, ldsp lds, int wid, int lane) const {
        const float* src = wid < 4 ? rss + u.pm * 256 + wid * 64 + lane : bias + (size_t)(u.pm < 64 ? (u.pm >> 4) : 4) * 1536 + u.pn * 256 + (wid - 4) * 64 + lane;
        __builtin_amdgcn_global_load_lds((const unsigned*)src, (LAS unsigned*)(lds + pg8::STAGE_BYTES + wid * 256), 4, 0, 0);
    }
    DI void operator()(const f32x4 (&acc)[2][2][4][2], const Unit& u, int wr, int wc, int fr, int fq) const {
        const int row0 = u.pm * 256 + wr * 64 + fr, colb = u.pn * 256 + wc * 32 + 8 * fq; const bool is_pc = u.pn < 2;
        const LAS float* sp = (const LAS float*)(ldsb + pg8::STAGE_BYTES); const int r8 = wc * 32 + 8 * fq; f32x4 bv[2][2];
#pragma unroll
        for (int bj = 0; bj < 2; ++bj) { bv[bj][0] = *(const LAS f32x4*)(sp + 256 + bj * 128 + r8); bv[bj][1] = *(const LAS f32x4*)(sp + 256 + bj * 128 + r8 + 4); }
#pragma unroll
        for (int ai = 0; ai < 2; ++ai)
#pragma unroll
            for (int m = 0; m < 4; ++m) {
                const int row = row0 + ai * 128 + m * 16; const float rs = rsqrtf(sp[ai * 128 + wr * 64 + m * 16 + fr] * (1.0f / 1024.0f) + EPS);
#pragma unroll
                for (int bj = 0; bj < 2; ++bj) {
                    const int c0 = colb + bj * 128; f32x4 v0 = acc[ai][bj][m][0] * rs + bv[bj][0], v1 = acc[ai][bj][m][1] * rs + bv[bj][1];
                    bf16_t* dst;
                    if (is_pc) dst = PC + (size_t)row * 512 + c0;
                    else { const f32x2 a = pg8::gelu_pk((f32x2){v0[0], v0[1]}), b = pg8::gelu_pk((f32x2){v0[2], v0[3]}), c = pg8::gelu_pk((f32x2){v1[0], v1[1]}), d = pg8::gelu_pk((f32x2){v1[2], v1[3]});
                        v0 = (f32x4){a.x, a.y, b.x, b.y}; v1 = (f32x4){c.x, c.y, d.x, d.y}; dst = Z + (size_t)row * 1024 + (c0 - 512); }
                    u32x4 w; w.x = pg8::cvt_pk_bf16(v0[0], v0[1]); w.y = pg8::cvt_pk_bf16(v0[2], v0[3]); w.z = pg8::cvt_pk_bf16(v1[0], v1[1]); w.w = pg8::cvt_pk_bf16(v1[2], v1[3]);
                    *(u32x4*)dst = w;
                }
            }
    }
};
struct EpiGU {
    static constexpr bool PERM = true, AFTER_DRAIN = false;
    static constexpr bool STAGED = true;
    bf16_t* ACT; const float* rss; const float* bias; ldsp ldsb;
    DI void stage(const Unit& u, ldsp lds, int wid, int lane) const {
        const float* src = wid < 4 ? rss + u.pm * 256 + wid * 64 + lane : bias + (size_t)(u.pm < 64 ? (u.pm >> 4) : 4) * 5632 + u.pn * 256 + (wid - 4) * 64 + lane;
        __builtin_amdgcn_global_load_lds((const unsigned*)src, (LAS unsigned*)(lds + pg8::STAGE_BYTES + wid * 256), 4, 0, 0);
    }
    DI void operator()(const f32x4 (&acc)[2][2][4][2], const Unit& u, int wr, int wc, int fr, int fq) const {
        const int row0 = u.pm * 256 + wr * 64 + fr, colb = u.pn * 256 + wc * 32 + 8 * fq, ff = u.pn * 128 + wc * 32 + 8 * fq;
        const LAS float* sp = (const LAS float*)(ldsb + pg8::STAGE_BYTES); const int r8 = wc * 32 + 8 * fq; f32x4 bv[2][2];
#pragma unroll
        for (int bj = 0; bj < 2; ++bj) { bv[bj][0] = *(const LAS f32x4*)(sp + 256 + bj * 128 + r8); bv[bj][1] = *(const LAS f32x4*)(sp + 256 + bj * 128 + r8 + 4); }
#pragma unroll
        for (int ai = 0; ai < 2; ++ai)
#pragma unroll
            for (int m = 0; m < 4; ++m) {
                const int row = row0 + ai * 128 + m * 16; const float rs = rsqrtf(sp[ai * 128 + wr * 64 + m * 16 + fr] * (1.0f / 1024.0f) + EPS);
                const f32x4 g0 = acc[ai][0][m][0] * rs + bv[0][0], g1 = acc[ai][0][m][1] * rs + bv[0][1], u0 = acc[ai][1][m][0] * rs + bv[1][0], u1 = acc[ai][1][m][1] * rs + bv[1][1];
                u32x4 w; w.x = pg8::cvt_pk_bf16(silu_f(g0[0]) * u0[0], silu_f(g0[1]) * u0[1]); w.y = pg8::cvt_pk_bf16(silu_f(g0[2]) * u0[2], silu_f(g0[3]) * u0[3]);
                w.z = pg8::cvt_pk_bf16(silu_f(g1[0]) * u1[0], silu_f(g1[1]) * u1[1]); w.w = pg8::cvt_pk_bf16(silu_f(g1[2]) * u1[2], silu_f(g1[3]) * u1[3]);
                *(u32x4*)(ACT + (size_t)row * DFF + ff) = w;
            }
    }
};
struct EpiRes {
    static constexpr bool PERM = true, AFTER_DRAIN = false, STAGED = true;
    const float* in_lat; const float* in_ctx; float* X; const float* gate;
    bf16_t* Hn; const float* wm; float* rss; ldsp ldsb;
    DI void stage(const Unit& u, ldsp lds, int wid, int lane) const {
        const int set = u.pm < 64 ? (u.pm >> 4) : 4;
        const float* src = wid < 4 ? gate + (size_t)set * 6144 + u.pn * 256 + wid * 64 + lane : wm + (size_t)set * 1024 + u.pn * 256 + (wid - 4) * 64 + lane;
        __builtin_amdgcn_global_load_lds((const unsigned*)src, (LAS unsigned*)(lds + pg8::STAGE_BYTES + wid * 256), 4, 0, 0);
    }
    DI void operator()(const f32x4 (&acc)[2][2][4][2], const Unit& u, int wr, int wc, int fr, int fq) const {
        const int row0 = u.pm * 256 + wr * 64 + fr, r8 = wc * 32 + 8 * fq, col0 = u.pn * 256 + r8;
        const float* ib = u.pm < 64 ? in_lat + (size_t)row0 * D + col0 : in_ctx + (size_t)(row0 - NLAT) * D + col0;
        const LAS float* sp = (const LAS float*)(ldsb + pg8::STAGE_BYTES) + r8;
#pragma unroll
        for (int ai = 0; ai < 2; ++ai) {
            f32x4 xin[4][2][2];
#pragma unroll
            for (int m = 0; m < 4; ++m) { const float* inp = ib + (size_t)(ai * 128 + m * 16) * D;
#pragma unroll
                for (int bj = 0; bj < 2; ++bj) { xin[m][bj][0] = *(const f32x4*)(inp + bj * 128); xin[m][bj][1] = *(const f32x4*)(inp + bj * 128 + 4); } }
#pragma unroll
            for (int m = 0; m < 4; ++m) { const int row = row0 + ai * 128 + m * 16; float* rowp = X + (size_t)row * D + col0; float ssq = 0.f;
#pragma unroll
                for (int bj = 0; bj < 2; ++bj) {
                    const f32x4 g0 = *(const LAS f32x4*)(sp + bj * 128), g1 = *(const LAS f32x4*)(sp + bj * 128 + 4);
                    const f32x4 x0 = xin[m][bj][0] + g0 * acc[ai][bj][m][0], x1 = xin[m][bj][1] + g1 * acc[ai][bj][m][1];
                    *(f32x4*)(rowp + bj * 128) = x0; *(f32x4*)(rowp + bj * 128 + 4) = x1;
                    if (Hn) { ssq += (x0[0] * x0[0] + x0[1] * x0[1] + x0[2] * x0[2] + x0[3] * x0[3]) + (x1[0] * x1[0] + x1[1] * x1[1] + x1[2] * x1[2] + x1[3] * x1[3]);
                        const f32x4 w0 = *(const LAS f32x4*)(sp + 256 + bj * 128), w1 = *(const LAS f32x4*)(sp + 256 + bj * 128 + 4);
                        const f32x4 a0 = x0 * w0, a1 = x1 * w1; u32x4 h; h.x = pg8::cvt_pk_bf16(a0[0], a0[1]); h.y = pg8::cvt_pk_bf16(a0[2], a0[3]); h.z = pg8::cvt_pk_bf16(a1[0], a1[1]); h.w = pg8::cvt_pk_bf16(a1[2], a1[3]);
                        *(u32x4*)(Hn + (size_t)row * D + col0 + bj * 128) = h; } }
                if (Hn) { ssq += xor_lane<16>(ssq); ssq += xor_lane<32>(ssq); if (fq == 0) __hip_atomic_fetch_add(rss + row, ssq, __ATOMIC_RELAXED, __HIP_MEMORY_SCOPE_AGENT); } }
            asm volatile("" ::: "memory"); }
    }
};

template <class Epi> DI void run_gemm(ldsp lds, const bf16_t* A, const bf16_t* Bt, int M, int N, int K, const Epi& E) {
    pg8::Gemm g{A, Bt, M, N, K}; pg8::StaticOrder S; S.init(M, N, (int)gridDim.x, (int)blockIdx.x);
    pg8::gemm_phase<Epi, pg8::StaticOrder, false>(lds, g, S, E, nullptr);
}

DI void static_map(int wgid, int nM, int nN, Unit& u) {
    const int nwg = nM * nN; { const int q = nwg / 8, r = nwg % 8, xcd = wgid % 8, off = wgid / 8; wgid = (xcd < r ? xcd * (q + 1) : r * (q + 1) + (xcd - r) * q) + off; }
    const int nig = 8 * nN, gid = wgid / nig, fm = gid * 8, gsz = (nM - fm) < 8 ? (nM - fm) : 8;
    u.pm = fm + ((wgid % nig) % gsz); u.pn = (wgid % nig) / gsz;
}
DI void publish_wave(unsigned* cnt) {
    __builtin_amdgcn_fence(__ATOMIC_RELEASE, "agent"); asm volatile("s_waitcnt vmcnt(0)" ::: "memory");
    if ((threadIdx.x & 63) == 0) __hip_atomic_fetch_add(cnt, 1u, __ATOMIC_RELAXED, __HIP_MEMORY_SCOPE_AGENT);
}
DI void wait_count(unsigned* cnt, unsigned need) {
    if (threadIdx.x == 0) { unsigned sp = 0; while (__hip_atomic_load(cnt, __ATOMIC_RELAXED, __HIP_MEMORY_SCOPE_AGENT) < need && ++sp < (1u << 22)) __builtin_amdgcn_s_sleep(2); }
    __syncthreads();
    __builtin_amdgcn_fence(__ATOMIC_ACQUIRE, "agent"); asm volatile("s_waitcnt vmcnt(0)" ::: "memory");
    __syncthreads();
}
DI void publish_block(unsigned* cnt) {
    __builtin_amdgcn_fence(__ATOMIC_RELEASE, "agent"); asm volatile("s_waitcnt vmcnt(0)" ::: "memory");
    __syncthreads();
    if (threadIdx.x == 0) __hip_atomic_fetch_add(cnt, 1u, __ATOMIC_RELAXED, __HIP_MEMORY_SCOPE_AGENT);
}
struct CtxFirstOrder {
    int nN, c, nctx, ntot, spec; unsigned* cnt;
    DI bool next(int i, Unit& u) const {
        const int nreg = ntot - spec; int L;
        if (c < 240) { L = i * 240 + c; if (L >= nreg) return false; } else { L = nreg + i * 16 + (c - 240); if (L >= ntot) return false; }
        if (L < nctx) { u.pm = 64 + L / nN; u.pn = L % nN; } else static_map(L - nctx, 64, nN, u);
        return true;
    }
    DI void a_ready(const Unit&) const {}
    DI void done(const Unit& u) const { if (u.pm >= 64) publish_wave(cnt); }
};
struct OneUnitOrder { int pm, pn; DI bool next(int i, Unit& u) const { u.pm = pm; u.pn = pn; return i == 0; } DI void a_ready(const Unit&) const {} DI void done(const Unit&) const {} };

DI void ph_init(const Params& P, ldsp lds) {
    const int tid = opaque_tid(), G = gridDim.x, bid = blockIdx.x;
    float* mod = (float*)(P.ws + WS_MOD); float* wmt = (float*)(P.ws + WS_WM);
    LAS float* sc = (LAS float*)lds;
    LAS float* red = (LAS float*)(lds + 5 * 1024 * 4);
    if (bid < 192) {
        for (int idx = tid; idx < 5120; idx += 512) { const int s = idx >> 10, k = idx & 1023; const float v = s < 4 ? P.c[s * 1024 + k] : P.c_ctx[k]; sc[idx] = silu_f(v); }
        __syncthreads();
        for (int u = bid; u < 192; u += G) {
            const int l = u / 48, cb = u % 48, c4 = (tid & 31) * 4, kq = tid >> 5;
            const float* wp = P.ada_w + ((size_t)l * 1024 + kq * 64) * 6144 + cb * 128 + c4;
            f32x4 a0 = (f32x4){0.f, 0.f, 0.f, 0.f}, a1 = a0, a2 = a0, a3 = a0, a4 = a0;
#pragma unroll 8
            for (int k = 0; k < 64; ++k) { const f32x4 w = *(const f32x4*)(wp + (size_t)k * 6144); const int kk = kq * 64 + k;
                a0 += w * sc[kk]; a1 += w * sc[1024 + kk]; a2 += w * sc[2048 + kk]; a3 += w * sc[3072 + kk]; a4 += w * sc[4096 + kk]; }
            *(LAS f32x4*)(red + (kq * 5 + 0) * 128 + c4) = a0; *(LAS f32x4*)(red + (kq * 5 + 1) * 128 + c4) = a1; *(LAS f32x4*)(red + (kq * 5 + 2) * 128 + c4) = a2;
            *(LAS f32x4*)(red + (kq * 5 + 3) * 128 + c4) = a3; *(LAS f32x4*)(red + (kq * 5 + 4) * 128 + c4) = a4;
            __syncthreads();
            for (int idx = tid; idx < 640; idx += 512) { const int s = idx >> 7, c2 = idx & 127; float v = P.ada_b[l * 6144 + cb * 128 + c2];
#pragma unroll
                for (int kk = 0; kk < 16; ++kk) v += red[(kk * 5 + s) * 128 + c2];
                mod[((size_t)l * 5 + s) * 6144 + cb * 128 + c2] = v;
                const int n = cb * 128 + c2, mch = n >> 10, col = n & 1023;
                if (mch == 1) wmt[(((size_t)l * 2 + 0) * 5 + s) * 1024 + col] = P.norm_w[(l * 2 + 0) * 1024 + col] * (1.0f + v);
                if (mch == 4) wmt[(((size_t)l * 2 + 1) * 5 + s) * 1024 + col] = P.norm_w[(l * 2 + 1) * 1024 + col] * (1.0f + v); }
            __syncthreads();
        }
    }
    { float* rc = (float*)(P.ws + WS_ROPE); float* rs = rc + 4352 * 64;
      for (int idx = bid * 512 + tid; idx < 4352 * 64; idx += G * 512) { const int pi = idx >> 6, d = idx & 63;
          float ps, pr, pc; if (pi < 4096) { ps = 256.f; pr = (float)(pi >> 6); pc = (float)(pi & 63); } else { ps = (float)(pi - 4096); pr = 0.f; pc = 0.f; }
          float ang; if (d < 16) ang = ps * powf(10000.f, -(float)d / 16.f); else if (d < 40) ang = pr * powf(10000.f, -(float)(d - 16) / 24.f); else ang = pc * powf(10000.f, -(float)(d - 40) / 24.f);
          float sv, cv; sincosf(ang, &sv, &cv); rc[idx] = cv; rs[idx] = sv; } }
    { bf16_t* sgw = (bf16_t*)(P.ws + WS_SGW); bf16_t* pwt = (bf16_t*)(P.ws + WS_PWT);
      for (int idx = bid * 512 + tid; idx < 2 * 4 * 128 * 128; idx += G * 512) { sgw[idx] = f2bf(P.sg_w[idx]);
          const int jg = idx >> 14, dd = (idx >> 7) & 127, cc = idx & 127; pwt[idx] = f2bf(P.pool_w[(size_t)jg * 16384 + cc * 128 + dd]); } }
}

DI const float* src_col(int mode, int p, const float* a, const float* b) {
    if (mode == 0) return a + p;
    const int U = p >> 8, r = p & 255;
    if (mode == 1) {
        if (p < 1024) { const int which = (r & 127) >> 6, dd = r & 63; return a + U * 256 + which * 128 + (r < 128 ? 0 : 64) + dd; }
        if (p < 2048) return a + p;
        return r < 128 ? a + 2048 + (U - 8) * 128 + r : a + 2560 + (U - 8) * 128 + (r - 128);
    }
    return r < 128 ? a + U * 128 + r : b + U * 128 + (r - 128);
}
DI void convert_w(ldsp lds, bf16_t* dst, int K, int Np, int ld, int mode, const float* a, const float* b, int& tile_ctr, int rank, int G, const float* shift, float* bias) {
    LAS float* tile = (LAS float*)lds;
    LAS float* red = (LAS float*)(lds + 64 * 132 * 4);
    const int npt = Np / 64, nkt = K / 128, ntiles = npt * nkt;
    int first = (rank - tile_ctr % G + G) % G;
    for (int t = first; t < ntiles; t += G) {
        const int pt = t % npt, kt = t / npt, p0 = pt * 64, k0 = kt * 128; const int tid = opaque_tid();
        { const int pg = tid & 15, kk = tid >> 4; const float* col = src_col(mode, p0 + 4 * pg, a, b) + (size_t)(k0 + kk) * ld; f32x4 v[4];
#pragma unroll
          for (int i = 0; i < 4; ++i) v[i] = *(const f32x4*)(col + (size_t)(32 * i) * ld);
#pragma unroll
          for (int i = 0; i < 4; ++i) { const int k = kk + 32 * i;
#pragma unroll
              for (int e = 0; e < 4; ++e) tile[(4 * pg + e) * 132 + k] = v[i][e]; }
          if (shift) { f32x4 pb[5];
#pragma unroll
              for (int s = 0; s < 5; ++s) { pb[s] = (f32x4){0.f, 0.f, 0.f, 0.f};
#pragma unroll
                  for (int i = 0; i < 4; ++i) pb[s] += v[i] * shift[s * 6144 + k0 + kk + 32 * i];
#pragma unroll
                  for (int e = 0; e < 4; ++e) { float x = pb[s][e]; x += xor_lane<16>(x); x += xor_lane<32>(x); pb[s][e] = x; } }
              if ((tid & 63) < 16) {
#pragma unroll
                  for (int s = 0; s < 5; ++s) *(LAS f32x4*)(red + ((tid >> 6) * 16 + pg) * 20 + 4 * s) = pb[s]; } } }
        __syncthreads();
        { const int k8 = tid & 15, pr = tid >> 4;
#pragma unroll
          for (int i = 0; i < 2; ++i) { const int p = pr + 32 * i; const f32x4 lo = *(const LAS f32x4*)(tile + p * 132 + 8 * k8), hi = *(const LAS f32x4*)(tile + p * 132 + 8 * k8 + 4);
              u32x4 o; o.x = pack2(lo[0], lo[1]); o.y = pack2(lo[2], lo[3]); o.z = pack2(hi[0], hi[1]); o.w = pack2(hi[2], hi[3]);
              *(u32x4*)(dst + (size_t)(p0 + p) * K + k0 + 8 * k8) = o; }
          if (shift && tid < 320) { const int s = tid >> 6, p = tid & 63, pg = p >> 2, e2 = p & 3; float x = 0.f;
#pragma unroll
              for (int w = 0; w < 8; ++w) x += red[(w * 16 + pg) * 20 + 4 * s + e2];
              __hip_atomic_fetch_add(bias + (size_t)s * Np + p0 + p, x, __ATOMIC_RELAXED, __HIP_MEMORY_SCOPE_AGENT); } }
        __syncthreads();
    }
    tile_ctr += ntiles;
}

DI void ph_norm0(const Params& P) {
    const int tid = opaque_tid(), lane = tid & 63, wv = tid >> 6, G = gridDim.x;
    bf16_t* H = (bf16_t*)(P.ws + WS_H); const float* wmt = (const float*)(P.ws + WS_WM); float* rss = (float*)(P.ws + WS_RSS);
    for (int row = (blockIdx.x * 8 + wv) * 2; row < MTOT; row += G * 16) {
        f32x4 v[2][4];
#pragma unroll
        for (int rr = 0; rr < 2; ++rr) { const int r = row + rr; const f32x4* xp = (const f32x4*)(r < NLAT ? P.x + (size_t)r * D : P.ctx + (size_t)(r - NLAT) * D);
#pragma unroll
            for (int j = 0; j < 4; ++j) v[rr][j] = xp[j * 64 + lane]; }
        const float* ws_ = wmt + (size_t)mod_set(row) * 1024;
#pragma unroll
        for (int rr = 0; rr < 2; ++rr) { float ss = 0.f;
#pragma unroll
            for (int j = 0; j < 4; ++j) ss += v[rr][j][0] * v[rr][j][0] + v[rr][j][1] * v[rr][j][1] + v[rr][j][2] * v[rr][j][2] + v[rr][j][3] * v[rr][j][3];
            ss = wave_sum(ss); if (lane == 0) rss[row + rr] = ss;
#pragma unroll
            for (int j = 0; j < 4; ++j) { const int c = (j * 64 + lane) * 4; const f32x4 h = v[rr][j] * *(const f32x4*)(ws_ + c); u32x2 o; o.x = pack2(h[0], h[1]); o.y = pack2(h[2], h[3]); *(u32x2*)(H + (size_t)(row + rr) * D + c) = o; } }
    }
}
DI void convert_inout(const Params& P, ldsp lds, int layer) {
    unsigned char* wb = P.ws + WS_WB; const int j = layer >> 1, G = gridDim.x, rank = (int)blockIdx.x; int ctr = 0;
    const float* shift = (const float*)(P.ws + WS_MOD) + (size_t)layer * 5 * 6144; float* bias = (float*)(P.ws + WS_BIN) + (size_t)layer * 5 * 3072;
    if (!(layer & 1)) { convert_w(lds, (bf16_t*)(wb + WB_IN), 1024, 3072, 3072, 1, P.even_w_in + (size_t)j * 1024 * 3072, nullptr, ctr, rank, G, shift, bias);
                        convert_w(lds, (bf16_t*)(wb + WB_OUT), 1024, 1024, 1024, 0, P.even_w_out + (size_t)j * 1024 * 1024, nullptr, ctr, rank, G, nullptr, nullptr); }
    else { convert_w(lds, (bf16_t*)(wb + WB_IN), 1024, 1536, 1536, 0, P.odd_w_in + (size_t)j * 1024 * 1536, nullptr, ctr, rank, G, shift, bias);
           convert_w(lds, (bf16_t*)(wb + WB_OUT), 1024, 1024, 1024, 0, P.odd_w_out + (size_t)j * 1024 * 1024, nullptr, ctr, rank, G, nullptr, nullptr); }
}
DI void convert_ffn_w(const Params& P, ldsp lds, int layer, int rank, int nidle);
DI void convert_ffn(const Params& P, ldsp lds, int layer, int nunits) {
    const int G = gridDim.x, busy = nunits % G, nidle = busy ? G - busy : G;
    convert_ffn_w(P, lds, layer, (int)blockIdx.x - (G - nidle), nidle);
}
DI void convert_ffn_w(const Params& P, ldsp lds, int layer, int rank, int nidle) {
    if (rank < 0 || rank >= nidle) return;
    unsigned char* wb = P.ws + WS_WB; int ctr = 0;
    convert_w(lds, (bf16_t*)(wb + WB_GU), 1024, 5632, 2816, 2, P.ffn_gate + (size_t)layer * 1024 * 2816, P.ffn_up + (size_t)layer * 1024 * 2816, ctr, rank, nidle,
              (const float*)(P.ws + WS_MOD) + (size_t)layer * 5 * 6144 + 3 * 1024, (float*)(P.ws + WS_BGU) + (size_t)layer * 5 * 5632);
    convert_w(lds, (bf16_t*)(wb + WB_DN), 2816, 1024, 1024, 0, P.ffn_down + (size_t)layer * 2816 * 1024, nullptr, ctr, rank, nidle, nullptr, nullptr);
}

DI int chunk_row0(int b, int chunk) { return chunk < 2 ? NLAT + b * 256 + chunk * 128 : b * 4096 + (chunk - 2) * 128; }
DI void kv_load(const Params& P, int unit, u32x4 (&kk)[4], u32x4 (&vv)[4]) {
    const int tid = opaque_tid(), m = tid & 127, dq = tid >> 7, bh = unit / 34, chunk = unit % 34, b = bh >> 2, h = bh & 3, row0 = chunk_row0(b, chunk);
    const bf16_t* Kb = (const bf16_t*)(P.ws + WS_P + SZ_HALF); const bf16_t* Vb = (const bf16_t*)(P.ws + WS_P + 2 * SZ_HALF);
#pragma unroll
    for (int c4 = 0; c4 < 4; ++c4) { const size_t go = (size_t)(row0 + m) * 512 + h * 128 + (dq * 4 + c4) * 8; kk[c4] = *(const u32x4*)(Kb + go); vv[c4] = *(const u32x4*)(Vb + go); }
}
DI void ret_kv_unit_pf(const Params& P, ldsp lds, int j, int unit, u32x4 (&kkp)[4], u32x4 (&vvp)[4], int next_unit);
DI void ret_kv_unit(const Params& P, ldsp lds, int j, int unit) { u32x4 kk[4], vv[4]; kv_load(P, unit, kk, vv); ret_kv_unit_pf(P, lds, j, unit, kk, vv, -1); }
DI void ret_kv_unit_pf(const Params& P, ldsp lds, int j, int unit, u32x4 (&kkp)[4], u32x4 (&vvp)[4], int next_unit) {
    const int tid = opaque_tid(), lane = tid & 63, wv = tid >> 6, r = lane & 15, q = lane >> 4;
    const int bh = unit / 34, chunk = unit % 34, b = bh >> 2, h = bh & 3, row0 = chunk_row0(b, chunk);
    const float l2f = log2_decay(P.ret_decay + j * 8 + h), l2b = log2_decay(P.ret_decay + j * 8 + 4 + h);
    const bf16_t* Kb = (const bf16_t*)(P.ws + WS_P + SZ_HALF); const bf16_t* Vb = (const bf16_t*)(P.ws + WS_P + 2 * SZ_HALF);
    LAS unsigned short* KT = (LAS unsigned short*)lds; LAS unsigned short* VTf = KT + 128 * 136; LAS unsigned short* VTb = VTf + 128 * 136;
    { const int m = tid & 127, dq = tid >> 7; const float zf = exp2f(l2f * (float)(127 - m)), zb = exp2f(l2b * (float)m);
#pragma unroll
      for (int c4 = 0; c4 < 4; ++c4) { const int d0 = (dq * 4 + c4) * 8; const u32x4 kk = kkp[c4], vv = vvp[c4];
#pragma unroll
          for (int e = 0; e < 8; ++e) { const unsigned kw = kk[e >> 1], vw = vv[e >> 1]; const unsigned short ks = (e & 1) ? (unsigned short)(kw >> 16) : (unsigned short)(kw & 0xffffu);
              const float vf = (e & 1) ? bfhi(vw) : bflo(vw);
              KT[(d0 + e) * 136 + m] = ks; VTf[(d0 + e) * 136 + m] = f2bf(vf * zf); VTb[(d0 + e) * 136 + m] = f2bf(vf * zb); } } }
    __syncthreads();
    if (next_unit >= 0) kv_load(P, next_unit, kkp, vvp);
    f32x4 af[8], ab[8];
#pragma unroll
    for (int n = 0; n < 8; ++n) { af[n] = (f32x4){0.f, 0.f, 0.f, 0.f}; ab[n] = (f32x4){0.f, 0.f, 0.f, 0.f}; }
#pragma unroll
    for (int s = 0; s < 4; ++s) {
        const bf16x8 xf = *(const LAS bf16x8*)(VTf + (16 * wv + r) * 136 + 32 * s + 8 * q), xb = *(const LAS bf16x8*)(VTb + (16 * wv + r) * 136 + 32 * s + 8 * q);
#pragma unroll
        for (int n = 0; n < 8; ++n) { const bf16x8 y = *(const LAS bf16x8*)(KT + (16 * n + r) * 136 + 32 * s + 8 * q); af[n] = mma(y, xf, af[n]); ab[n] = mma(y, xb, ab[n]); }
    }
    bf16_t* kvf = (bf16_t*)(P.ws + WS_KV) + ((size_t)(bh * 34 + chunk) * 2) * 16384 + (size_t)(16 * wv + r) * 128 + 4 * q; bf16_t* kvb = kvf + 16384;
#pragma unroll
    for (int n = 0; n < 8; ++n) { u32x2 wf, wb2; wf.x = pack2(af[n][0], af[n][1]); wf.y = pack2(af[n][2], af[n][3]); wb2.x = pack2(ab[n][0], ab[n][1]); wb2.y = pack2(ab[n][2], ab[n][3]);
        *(u32x2*)(kvf + 16 * n) = wf; *(u32x2*)(kvb + 16 * n) = wb2; }
    __syncthreads();
}
DI void conv_unit(const Params& P, ldsp lds, int j, int ct) {
    const int tid = opaque_tid(), lane = tid & 63, wv = tid >> 6;
    const bf16_t* U = (const bf16_t*)(P.ws + WS_P + 4 * SZ_HALF); bf16_t* MIX = (bf16_t*)(P.ws + WS_MIX);
    const int row0 = ct * 32; int s0, len; if (row0 < NLAT) { s0 = row0 & ~4095; len = 4096; } else { s0 = NLAT + ((row0 - NLAT) & ~255); len = 256; }
    LAS unsigned* uw = (LAS unsigned*)lds;
    LAS float* wl = (LAS float*)(lds + 32 * 516 * 4);
    LAS float* cb = (LAS float*)lds;
#pragma unroll
    for (int it = 0; it < 8; ++it) { const int idx = tid + 512 * it; if (idx < 62 * 64) { const int rr = row0 - 15 + (idx >> 6), ch = idx & 63;
        u32x4 v = (u32x4){0u, 0u, 0u, 0u}; if (rr >= s0 && rr < s0 + len) v = *(const u32x4*)(U + (size_t)rr * 512 + ch * 8);
        *(LAS u32x4*)(uw + (idx >> 6) * 256 + ch * 4) = v; } }
    __syncthreads();
    const int cp = tid & 255, half = tid >> 8;
    f32x2 acc2[16];
#pragma unroll
    for (int th = 0; th < 2; ++th) { f32x2 xw[38];
#pragma unroll
      for (int i = 0; i < 38; ++i) { const unsigned w = uw[(16 * half + 8 * th + i) * 256 + cp]; xw[i] = (f32x2){bflo(w), bfhi(w)}; }
#pragma unroll
      for (int t = 0; t < 8; ++t) acc2[8 * th + t] = (f32x2){0.f, 0.f};
#pragma unroll
      for (int k = 0; k < 31; ++k) { const f32x2 w = *(const LAS f32x2*)(wl + k * 512 + 2 * cp);
#pragma unroll
          for (int t = 0; t < 8; ++t) acc2[8 * th + t] = acc2[8 * th + t] + w * xw[t + k]; }
      asm volatile("" ::: "memory"); }
    __syncthreads();
#pragma unroll
    for (int t = 0; t < 16; ++t) *(LAS f32x2*)(cb + (16 * half + t) * 516 + 2 * cp) = acc2[t];
    __syncthreads();
    { const f32x4 lw0 = *(const f32x4*)(P.conv_ln_w + j * 512 + 8 * lane), lw1 = *(const f32x4*)(P.conv_ln_w + j * 512 + 8 * lane + 4);
      const f32x4 lb0 = *(const f32x4*)(P.conv_ln_b + j * 512 + 8 * lane), lb1 = *(const f32x4*)(P.conv_ln_b + j * 512 + 8 * lane + 4);
#pragma unroll
      for (int tt = 0; tt < 4; ++tt) { const int tok = 4 * wv + tt;
          f32x4 v0 = *(const LAS f32x4*)(cb + tok * 516 + 8 * lane), v1 = *(const LAS f32x4*)(cb + tok * 516 + 8 * lane + 4);
          const float mean = wave_sum(v0[0] + v0[1] + v0[2] + v0[3] + v1[0] + v1[1] + v1[2] + v1[3]) * (1.0f / 512.0f);
          v0 = v0 - mean; v1 = v1 - mean;
          const float var = wave_sum(v0[0] * v0[0] + v0[1] * v0[1] + v0[2] * v0[2] + v0[3] * v0[3] + v1[0] * v1[0] + v1[1] * v1[1] + v1[2] * v1[2] + v1[3] * v1[3]) * (1.0f / 512.0f);
          const float rstd = rsqrtf(var + EPS);
          v0 = v0 * rstd * lw0 + lb0; v1 = v1 * rstd * lw1 + lb1;
          u32x4 o; o.x = pack2(silu_f(v0[0]), silu_f(v0[1])); o.y = pack2(silu_f(v0[2]), silu_f(v0[3])); o.z = pack2(silu_f(v1[0]), silu_f(v1[1])); o.w = pack2(silu_f(v1[2]), silu_f(v1[3]));
          *(u32x4*)(MIX + (size_t)(row0 + tok) * D + 512 + 8 * lane) = o; } }
    __syncthreads();
}
DI void ph_ret_kv_conv(const Params& P, ldsp lds, int j, int n_conv_tiles) {
    const int G = gridDim.x;
    for (int u = blockIdx.x; u < 544; u += G) ret_kv_unit(P, lds, j, u);
    if (G - 1 - (int)blockIdx.x < n_conv_tiles) { const int tid = opaque_tid(); LAS float* wl = (LAS float*)(lds + 32 * 516 * 4);
#pragma unroll
        for (int it = 0; it < 8; ++it) { const int idx = tid + 512 * it; if (idx < 31 * 128) *(LAS f32x4*)(wl + idx * 4) = *(const f32x4*)(P.conv_w + (size_t)j * 31 * 512 + idx * 4); } }
    for (int u = G - 1 - (int)blockIdx.x; u < n_conv_tiles; u += G) conv_unit(P, lds, j, u);
}
template <class EpiT> DI void ph_ret_kv_conv_ho(const Params& P, ldsp lds, int j, int layer, int nG, bool ctx_conv, const EpiT& E, unsigned* cnt) {
    const int c = (int)blockIdx.x;
    if (c < nG) { const int pm = layer == 0 ? 64 + c / 12 : 64 + c / 4, pn = layer == 0 ? c % 12 : 2 + c % 4;
        pg8::Gemm g{(const bf16_t*)(P.ws + WS_H), (const bf16_t*)(P.ws + WS_WB + WB_IN), MTOT, 3072, 1024}; OneUnitOrder S{pm, pn};
        pg8::gemm_phase<EpiT, OneUnitOrder, false>(lds, g, S, E, nullptr);
        publish_block(cnt); }
    { const int u0 = (c >> 5) * 34 + 2 + (c & 31), u1 = ((c + 256) >> 5) * 34 + 2 + ((c + 256) & 31); u32x4 kk[4], vv[4]; kv_load(P, u0, kk, vv);
      ret_kv_unit_pf(P, lds, j, u0, kk, vv, u1); ret_kv_unit_pf(P, lds, j, u1, kk, vv, -1); }
    { const int tid = opaque_tid(); LAS float* wl = (LAS float*)(lds + 32 * 516 * 4);
#pragma unroll
      for (int it = 0; it < 8; ++it) { const int idx = tid + 512 * it; if (idx < 31 * 128) *(LAS f32x4*)(wl + idx * 4) = *(const f32x4*)(P.conv_w + (size_t)j * 31 * 512 + idx * 4); } }
    if (c >= nG) { conv_unit(P, lds, j, 255 - c); conv_unit(P, lds, j, 511 - c); }
    if (c >= 48 && c < 48 + 2 * nG) { const int k = c - 48, cc = k >> 1; conv_unit(P, lds, j, (k & 1) ? 511 - cc : 255 - cc); }
    if (c >= 144 && c < 176) { wait_count(cnt, (unsigned)nG); const int u2 = c - 144; ret_kv_unit(P, lds, j, (u2 >> 1) * 34 + (u2 & 1)); }
    if (ctx_conv && c >= 176 && c < 208) { wait_count(cnt, (unsigned)nG); conv_unit(P, lds, j, 512 + (c - 176)); }
}
constexpr size_t KV_HALF = (size_t)16 * 34 * 2 * 16384 * 2;
DI void ph_scan(const Params& P, int j) {
    const u32x4* kv = (const u32x4*)(P.ws + WS_KV); u32x4* sp = (u32x4*)(P.ws + WS_KV + KV_HALF);
    for (int idx = blockIdx.x * 512 + opaque_tid(); idx < 16 * 2 * 2048; idx += gridDim.x * 512) {
        const int bh = idx >> 12, dir = (idx >> 11) & 1, e8 = idx & 2047, h = bh & 3;
        const float dec = exp2f(128.0f * log2_decay(P.ret_decay + j * 8 + dir * 4 + h));
        float carry[8];
#pragma unroll
        for (int e = 0; e < 8; ++e) carry[e] = 0.f;
#pragma unroll 1
        for (int k0 = 0; k0 < 34; k0 += 17) { u32x4 v[17];
#pragma unroll
            for (int i = 0; i < 17; ++i) { const int k = k0 + i, c = dir == 0 ? k : (k < 2 ? 1 - k : 35 - k); v[i] = kv[((size_t)(bh * 34 + c) * 2 + dir) * 2048 + e8]; }
#pragma unroll
            for (int i = 0; i < 17; ++i) { const int k = k0 + i, c = dir == 0 ? k : (k < 2 ? 1 - k : 35 - k);
                u32x4 o; o.x = pack2(carry[0], carry[1]); o.y = pack2(carry[2], carry[3]); o.z = pack2(carry[4], carry[5]); o.w = pack2(carry[6], carry[7]);
                sp[((size_t)(bh * 34 + c) * 2 + dir) * 2048 + e8] = o;
                carry[0] = carry[0] * dec + bflo(v[i].x); carry[1] = carry[1] * dec + bfhi(v[i].x); carry[2] = carry[2] * dec + bflo(v[i].y); carry[3] = carry[3] * dec + bfhi(v[i].y);
                carry[4] = carry[4] * dec + bflo(v[i].z); carry[5] = carry[5] * dec + bfhi(v[i].z); carry[6] = carry[6] * dec + bflo(v[i].w); carry[7] = carry[7] * dec + bfhi(v[i].w); } }
    }
}
DI void ret_out_unit(const Params& P, ldsp lds, int j, int bh, int chunk, unsigned* cnt) {
    const int tid = opaque_tid(), lane = tid & 63, wv = tid >> 6, r = lane & 15, q = lane >> 4;
    const int b = bh >> 2, h = bh & 3, row0 = chunk_row0(b, chunk);
    const float l2f = log2_decay(P.ret_decay + j * 8 + h), l2b = log2_decay(P.ret_decay + j * 8 + 4 + h);
    const bf16_t* Qb = (const bf16_t*)(P.ws + WS_P); const bf16_t* Kb = (const bf16_t*)(P.ws + WS_P + SZ_HALF); const bf16_t* Vb = (const bf16_t*)(P.ws + WS_P + 2 * SZ_HALF);
    const bf16_t* Gb = (const bf16_t*)(P.ws + WS_P + 3 * SZ_HALF); bf16_t* MIX = (bf16_t*)(P.ws + WS_MIX);
    LAS unsigned short* Ks = (LAS unsigned short*)lds; LAS unsigned short* VT = Ks + 128 * 136; LAS unsigned short* SfT = VT + 128 * 136; LAS unsigned short* SbT = SfT + 128 * 136;
#pragma unroll
    for (int it = 0; it < 4; ++it) { const int idx = tid + 512 * it, jj = idx >> 4, ch = idx & 15;
        *(LAS u32x4*)(Ks + jj * 136 + ch * 8) = *(const u32x4*)(Kb + (size_t)(row0 + jj) * 512 + h * 128 + ch * 8); }
    { const int m = tid & 127, dq = tid >> 7;
#pragma unroll
      for (int c4 = 0; c4 < 4; ++c4) { const int d0 = (dq * 4 + c4) * 8; const u32x4 vv = *(const u32x4*)(Vb + (size_t)(row0 + m) * 512 + h * 128 + d0);
#pragma unroll
          for (int e = 0; e < 8; ++e) { const unsigned vw = vv[e >> 1]; VT[(d0 + e) * 136 + m] = (e & 1) ? (unsigned short)(vw >> 16) : (unsigned short)(vw & 0xffffu); } } }
    { const bf16_t* sf = (const bf16_t*)(P.ws + WS_KV + KV_HALF) + ((size_t)(bh * 34 + chunk) * 2) * 16384; const bf16_t* sb = sf + 16384;
#pragma unroll
      for (int it = 0; it < 4; ++it) { const int idx = tid + 512 * it, e = idx >> 4, ch = idx & 15;
          *(LAS u32x4*)(SfT + e * 136 + ch * 8) = *(const u32x4*)(sf + e * 128 + ch * 8); *(LAS u32x4*)(SbT + e * 136 + ch * 8) = *(const u32x4*)(sb + e * 128 + ch * 8); } }
    const int i = 16 * wv + r; const size_t grow = (size_t)(row0 + i);
    bf16x8 xq[4];
#pragma unroll
    for (int s = 0; s < 4; ++s) xq[s] = *(const bf16x8*)(Qb + grow * 512 + h * 128 + 32 * s + 8 * q);
    __syncthreads();
    f32x4 sc[8];
#pragma unroll
    for (int jt = 0; jt < 8; ++jt) { sc[jt] = (f32x4){0.f, 0.f, 0.f, 0.f};
#pragma unroll
        for (int s = 0; s < 4; ++s) { const bf16x8 y = *(const LAS bf16x8*)(Ks + (16 * jt + r) * 136 + 32 * s + 8 * q); sc[jt] = mma(y, xq[s], sc[jt]); } }
    bf16x8 xp[4];
#pragma unroll
    for (int s = 0; s < 4; ++s) { u32x4 w;
#pragma unroll
        for (int half = 0; half < 2; ++half) { const int jt = 2 * s + half; float p[4];
#pragma unroll
            for (int t = 0; t < 4; ++t) { const int dl = i - (16 * jt + 4 * q + t); const float f = dl >= 0 ? exp2f(l2f * (float)dl) : exp2f(l2b * (float)(-dl - 1)); p[t] = sc[jt][t] * f; }
            w[2 * half] = pack2(p[0], p[1]); w[2 * half + 1] = pack2(p[2], p[3]); }
        xp[s] = __builtin_bit_cast(bf16x8, w); }
    const float xif = exp2f(l2f * (float)(i + 1)), xib = exp2f(l2b * (float)(127 - i));
    f32x4 o[8]; float ss = 0.f;
#pragma unroll
    for (int et = 0; et < 8; ++et) { f32x4 a = (f32x4){0.f, 0.f, 0.f, 0.f}, tf = a, tb = a;
#pragma unroll
        for (int s = 0; s < 4; ++s) { const LAS unsigned short* vp = VT + (16 * et + r) * 136 + 32 * s + 4 * q;
            const u32x2 y0 = *(const LAS u32x2*)vp, y1 = *(const LAS u32x2*)(vp + 16); const u32x4 yw = (u32x4){y0.x, y0.y, y1.x, y1.y};
            a = mma(__builtin_bit_cast(bf16x8, yw), xp[s], a);
            tf = mma(*(const LAS bf16x8*)(SfT + (16 * et + r) * 136 + 32 * s + 8 * q), xq[s], tf);
            tb = mma(*(const LAS bf16x8*)(SbT + (16 * et + r) * 136 + 32 * s + 8 * q), xq[s], tb); }
        a = a + tf * xif + tb * xib; o[et] = a; ss += a[0] * a[0] + a[1] * a[1] + a[2] * a[2] + a[3] * a[3]; }
    ss += xor_lane<16>(ss); ss += xor_lane<32>(ss);
    const float rinv = rsqrtf(ss * (1.0f / 128.0f) + EPS);
#pragma unroll
    for (int et = 0; et < 8; ++et) { const u32x2 gw = *(const u32x2*)(Gb + grow * 512 + h * 128 + 16 * et + 4 * q);
        u32x2 w; w.x = pack2(silu_f(bflo(gw.x)) * o[et][0] * rinv, silu_f(bfhi(gw.x)) * o[et][1] * rinv); w.y = pack2(silu_f(bflo(gw.y)) * o[et][2] * rinv, silu_f(bfhi(gw.y)) * o[et][3] * rinv);
        *(u32x2*)(MIX + grow * D + h * 128 + 16 * et + 4 * q) = w; }
    if (cnt) publish_block(cnt); else __syncthreads();
}
DI void ph_ret_out(const Params& P, ldsp lds, int j, bool with_ctx, unsigned* cnt  ) {
    if (cnt) {
        const int c = (int)blockIdx.x;
        for (int k = 0;; ++k) { int u; if (c < 240) { u = c + 240 * k; if (u >= 528) break; } else { if (k) break; u = 528 + (c - 240); }
            if (u < 32) ret_out_unit(P, lds, j, u >> 1, u & 1, cnt); else ret_out_unit(P, lds, j, (u - 32) >> 5, 2 + ((u - 32) & 31), nullptr); }
        return;
    }
    const int nper = with_ctx ? 34 : 32, n = 16 * nper;
    for (int u = blockIdx.x; u < n; u += gridDim.x) { const int bh = u / nper, chunk = u % nper + (with_ctx ? 0 : 2); ret_out_unit(P, lds, j, bh, chunk, nullptr); }
}

DI void sg_unit(const Params& P, ldsp lds, int j, int chunk, int g, unsigned* cnt) {
    const int tid = opaque_tid(), lane = tid & 63, wv = tid >> 6, r = lane & 15, q = lane >> 4, row0 = chunk * 128;
    const bf16_t* Z = (const bf16_t*)(P.ws + WS_P + SZ_HALF); bf16_t* MIX = (bf16_t*)(P.ws + WS_MIX);
    LAS f32x2* st = (LAS f32x2*)lds; LAS unsigned short* VnT = (LAS unsigned short*)(lds + 1024);
    { const int p = tid >> 2, part = tid & 3; const bf16_t* zp = Z + (size_t)(row0 + p) * 1024 + 512 + part * 128; float s1 = 0.f, s2 = 0.f;
#pragma unroll
      for (int i = 0; i < 16; ++i) { const u32x4 w = *(const u32x4*)(zp + 8 * i);
          const float f0 = bflo(w.x), f1 = bfhi(w.x), f2 = bflo(w.y), f3 = bfhi(w.y), f4 = bflo(w.z), f5 = bfhi(w.z), f6 = bflo(w.w), f7 = bfhi(w.w);
          s1 += ((f0 + f1) + (f2 + f3)) + ((f4 + f5) + (f6 + f7)); s2 += ((f0 * f0 + f1 * f1) + (f2 * f2 + f3 * f3)) + ((f4 * f4 + f5 * f5) + (f6 * f6 + f7 * f7)); }
      s1 += xor_lane<1>(s1); s1 += xor_lane<2>(s1); s2 += xor_lane<1>(s2); s2 += xor_lane<2>(s2);
      const float mean = s1 * (1.0f / 512.0f); float var = s2 * (1.0f / 512.0f) - mean * mean; var = var > 0.f ? var : 0.f;
      if (part == 0) st[p] = (f32x2){mean, rsqrtf(var + EPS)}; }
    __syncthreads();
    { const int p = tid & 127, cq = tid >> 7; const f32x2 s = st[p];
#pragma unroll
      for (int c4 = 0; c4 < 4; ++c4) { const int c0 = (cq * 4 + c4) * 8, ch = g * 128 + c0; const u32x4 w = *(const u32x4*)(Z + (size_t)(row0 + p) * 1024 + 512 + ch);
          const f32x4 lw0 = *(const f32x4*)(P.sg_ln_w + j * 512 + ch), lw1 = *(const f32x4*)(P.sg_ln_w + j * 512 + ch + 4), lb0 = *(const f32x4*)(P.sg_ln_b + j * 512 + ch), lb1 = *(const f32x4*)(P.sg_ln_b + j * 512 + ch + 4);
#pragma unroll
          for (int e = 0; e < 8; ++e) { const unsigned ww = w[e >> 1]; const float vf = (e & 1) ? bfhi(ww) : bflo(ww); const float lwv = e < 4 ? lw0[e & 3] : lw1[e & 3], lbv = e < 4 ? lb0[e & 3] : lb1[e & 3];
              VnT[(c0 + e) * 136 + p] = f2bf((vf - s.x) * s.y * lwv + lbv); } } }
    const bf16_t* W = (const bf16_t*)(P.ws + WS_SGW) + (size_t)(j * 4 + g) * 16384; const int qq = 16 * wv + r;
    bf16x8 xw[4];
#pragma unroll
    for (int s = 0; s < 4; ++s) xw[s] = *(const bf16x8*)(W + qq * 128 + 32 * s + 8 * q);
    __syncthreads();
    const float bias = P.sg_b[(j * 4 + g) * 128 + qq];
#pragma unroll
    for (int ct = 0; ct < 8; ++ct) { f32x4 a = (f32x4){0.f, 0.f, 0.f, 0.f};
#pragma unroll
        for (int s = 0; s < 4; ++s) a = mma(*(const LAS bf16x8*)(VnT + (16 * ct + r) * 136 + 32 * s + 8 * q), xw[s], a);
        const size_t go = (size_t)(row0 + qq) * 1024 + g * 128 + 16 * ct + 4 * q; const u32x2 uw = *(const u32x2*)(Z + go);
        u32x2 w; w.x = pack2(bflo(uw.x) * (a[0] + bias), bfhi(uw.x) * (a[1] + bias)); w.y = pack2(bflo(uw.y) * (a[2] + bias), bfhi(uw.y) * (a[3] + bias));
        *(u32x2*)(MIX + go + 512) = w; }
    if (cnt) publish_block(cnt); else __syncthreads();
}
template <int W> DI void pool_frag(const LAS unsigned short* T, int lr, int q, float inv, bf16x8 (&xm)[4]) {
    constexpr int left = W / 2;
#pragma unroll
    for (int s = 0; s < 4; ++s) { const LAS unsigned short* base = T + (lr + 8 - left) * 136 + 32 * s + 8 * q;
        float acc[8];
#pragma unroll
        for (int e = 0; e < 8; ++e) acc[e] = 0.f;
#pragma unroll
        for (int i = 0; i < W; ++i) { const u32x4 v = *(const LAS u32x4*)(base + i * 136);
            acc[0] += bflo(v.x); acc[1] += bfhi(v.x); acc[2] += bflo(v.y); acc[3] += bfhi(v.y); acc[4] += bflo(v.z); acc[5] += bfhi(v.z); acc[6] += bflo(v.w); acc[7] += bfhi(v.w); }
        const u32x4 t = *(const LAS u32x4*)(base + left * 136); u32x4 o;
        o.x = pack2(acc[0] * inv - bflo(t.x), acc[1] * inv - bfhi(t.x)); o.y = pack2(acc[2] * inv - bflo(t.y), acc[3] * inv - bfhi(t.y));
        o.z = pack2(acc[4] * inv - bflo(t.z), acc[5] * inv - bfhi(t.z)); o.w = pack2(acc[6] * inv - bflo(t.w), acc[7] * inv - bfhi(t.w));
        xm[s] = __builtin_bit_cast(bf16x8, o); }
}
DI void pool_unit(const Params& P, ldsp lds, int j, int chunk, int g, unsigned* cnt) {
    const int tid = opaque_tid(), lane = tid & 63, wv = tid >> 6, r = lane & 15, q = lane >> 4, row0 = chunk * 128;
    const bf16_t* PC = (const bf16_t*)(P.ws + WS_P); bf16_t* MIX = (bf16_t*)(P.ws + WS_MIX);
    int s0, len; if (row0 < NLAT) { s0 = row0 & ~4095; len = 4096; } else { s0 = NLAT + ((row0 - NLAT) & ~255); len = 256; }
    LAS unsigned short* T = (LAS unsigned short*)lds;
#pragma unroll
    for (int it = 0; it < 5; ++it) { const int idx = tid + 512 * it; if (idx < 144 * 16) { const int lrow = idx >> 4, ch = idx & 15, rr = row0 - 8 + lrow;
        u32x4 v = (u32x4){0u, 0u, 0u, 0u}; if (rr >= s0 && rr < s0 + len) v = *(const u32x4*)(PC + (size_t)rr * 512 + g * 128 + ch * 8);
        *(LAS u32x4*)(T + lrow * 136 + ch * 8) = v; } }
    LAS unsigned short* Wl = T + 144 * 136;
    { const bf16_t* Wg = (const bf16_t*)(P.ws + WS_PWT) + (size_t)(j * 4 + g) * 16384;
#pragma unroll
      for (int it = 0; it < 4; ++it) { const int idx = tid + 512 * it, dd = idx >> 4, ch = idx & 15; *(LAS u32x4*)(Wl + dd * 136 + ch * 8) = *(const u32x4*)(Wg + dd * 128 + ch * 8); } }
    __syncthreads();
    const int lr = 16 * wv + r, row = row0 + lr, w = 2 << g, left = w >> 1, right = w - 1 - left;
    int lo = row - left, hi = row + right; if (lo < s0) lo = s0; if (hi > s0 + len - 1) hi = s0 + len - 1;
    const float inv = 1.0f / (float)(hi - lo + 1);
    bf16x8 xm[4];
    if (g == 0) pool_frag<2>(T, lr, q, inv, xm); else if (g == 1) pool_frag<4>(T, lr, q, inv, xm);
    else if (g == 2) pool_frag<8>(T, lr, q, inv, xm); else pool_frag<16>(T, lr, q, inv, xm);
#pragma unroll
    for (int dt = 0; dt < 8; ++dt) { f32x4 a = (f32x4){0.f, 0.f, 0.f, 0.f};
#pragma unroll
        for (int s = 0; s < 4; ++s) a = mma(*(const LAS bf16x8*)(Wl + (16 * dt + r) * 136 + 32 * s + 8 * q), xm[s], a);
        const int dc = g * 128 + 16 * dt + 4 * q; const f32x4 ps = *(const f32x4*)(P.pool_scale + j * 512 + dc);
        u32x2 o; o.x = pack2(a[0] * ps[0], a[1] * ps[1]); o.y = pack2(a[2] * ps[2], a[3] * ps[3]);
        *(u32x2*)(MIX + (size_t)row * D + dc) = o; }
    if (cnt) publish_block(cnt); else __syncthreads();
}
DI void ph_oddmix(const Params& P, ldsp lds, int j, int nchunks, unsigned* cnt  ) {
    const int G = gridDim.x, n = nchunks * 4;
    if (cnt) {
        const int c = (int)blockIdx.x;
        for (int k = 0;; ++k) { int u; if (c < 240) { u = c + 240 * k; if (u >= 528) break; } else { if (k) break; u = 528 + (c - 240); }
            if (u < 32) sg_unit(P, lds, j, 128 + (u & 7), u >> 3, cnt); else sg_unit(P, lds, j, (u - 32) & 127, (u - 32) >> 7, nullptr); }
        for (int k = 0;; ++k) { int u; if (c < 240) { u = (239 - c) + 240 * k; if (u >= 528) break; } else { if (k) break; u = 528 + (c - 240); }
            if (u < 32) pool_unit(P, lds, j, 128 + (u & 7), u >> 3, cnt); else pool_unit(P, lds, j, (u - 32) & 127, (u - 32) >> 7, nullptr); }
        return;
    }
    for (int u = blockIdx.x; u < n; u += G) sg_unit(P, lds, j, u % nchunks, u / nchunks, nullptr);
    for (int u = G - 1 - (int)blockIdx.x; u < n; u += G) pool_unit(P, lds, j, u % nchunks, u / nchunks, nullptr);
}
DI void ph_final(const Params& P) {
    const int tid = opaque_tid(), lane = tid & 63, wv = tid >> 6; const float* xr = (const float*)(P.ws + WS_XR);
    f32x4 fw[4];
#pragma unroll
    for (int j = 0; j < 4; ++j) fw[j] = *(const f32x4*)(P.final_w + (j * 64 + lane) * 4);
    for (int row = (blockIdx.x * 8 + wv) * 2; row < NLAT; row += gridDim.x * 16) {
        f32x4 v[2][4]; float ss[2] = {0.f, 0.f};
#pragma unroll
        for (int rr = 0; rr < 2; ++rr)
#pragma unroll
            for (int j = 0; j < 4; ++j) v[rr][j] = ((const f32x4*)(xr + (size_t)(row + rr) * D))[j * 64 + lane];
#pragma unroll
        for (int rr = 0; rr < 2; ++rr) {
#pragma unroll
            for (int j = 0; j < 4; ++j) ss[rr] += v[rr][j][0] * v[rr][j][0] + v[rr][j][1] * v[rr][j][1] + v[rr][j][2] * v[rr][j][2] + v[rr][j][3] * v[rr][j][3];
            ss[rr] = wave_sum(ss[rr]); const float rstd = rsqrtf(ss[rr] * (1.0f / 1024.0f) + EPS);
#pragma unroll
            for (int j = 0; j < 4; ++j) *(f32x4*)(P.out + (size_t)(row + rr) * D + (j * 64 + lane) * 4) = v[rr][j] * rstd * fw[j]; }
    }
}

__global__ void __launch_bounds__(512) mega(Params P) {
    extern __shared__ __attribute__((aligned(16))) unsigned char smem[];
    ldsp lds = (ldsp)smem;
    cg::grid_group grid = cg::this_grid();
    unsigned char* ws = P.ws; unsigned char* wb = ws + WS_WB;
    bf16_t* H = (bf16_t*)(ws + WS_H); bf16_t* MIX = (bf16_t*)(ws + WS_MIX); bf16_t* ACT = (bf16_t*)(ws + WS_P); float* XR = (float*)(ws + WS_XR);
    const float* mod = (const float*)(ws + WS_MOD); const float* wmt = (const float*)(ws + WS_WM); float* rss = (float*)(ws + WS_RSS);
    const float* bin = (const float*)(ws + WS_BIN); const float* bgu = (const float*)(ws + WS_BGU);
    if (blockIdx.x == 0) for (int k = threadIdx.x; k < XCD_BAR_WORDS; k += 512) __hip_atomic_store((unsigned*)(ws + WS_BAR) + k, 0u, __ATOMIC_RELAXED, __HIP_MEMORY_SCOPE_AGENT);
    for (int k = blockIdx.x * 512 + threadIdx.x; k < (int)((WS_ZEND - WS_ZERO) / 4) + CNT_WORDS; k += gridDim.x * 512) __hip_atomic_store((unsigned*)(ws + WS_ZERO) + k, 0u, __ATOMIC_RELAXED, __HIP_MEMORY_SCOPE_AGENT);
    if (threadIdx.x < 4) ((LAS unsigned*)(lds + LDS_WORK))[threadIdx.x] = 0u;
    ph_init(P, lds); grid.sync();
    const XcdBarrier bar = xcd_barrier_post((unsigned*)(ws + WS_BAR), (volatile LAS unsigned*)(lds + LDS_WORK));
#define GSYNC() xcd_barrier(bar)
    ph_norm0(P); convert_inout(P, lds, 0); GSYNC();
#pragma unroll 1
    for (int i = 0; i < 4; ++i) {
        const int j = i >> 1; const bool even = !(i & 1);
        const int M1 = i <= 2 ? MTOT : NLAT, M2 = i <= 1 ? MTOT : NLAT;
        const float* rss1 = rss + (size_t)(i * 2 + 0) * MTOT; float* rss2 = rss + (size_t)(i * 2 + 1) * MTOT; float* rss1n = rss + (size_t)(i * 2 + 2) * MTOT;
        const bool ho = (M2 == MTOT) && gridDim.x == 256;
        unsigned* cnt2 = (unsigned*)(ws + WS_CNT) + (8 + i) * 16;
        const EpiRes Eout{i == 0 ? P.x : XR, i == 0 ? P.ctx : XR + (size_t)NLAT * D, XR, mod + (size_t)i * 5 * 6144 + 2 * 1024, H, wmt + (size_t)(i * 2 + 1) * 5 * 1024, rss2, lds};
#define g2c_tail() do { if (blockIdx.x >= 240) { wait_count(cnt2, even ? 32u : 64u); \
            pg8::Gemm g{MIX, (const bf16_t*)(wb + WB_OUT), MTOT, 1024, 1024}; OneUnitOrder S{64 + ((int)blockIdx.x - 240) / 4, ((int)blockIdx.x - 240) % 4}; \
            pg8::gemm_phase<EpiRes, OneUnitOrder, false>(lds, g, S, Eout, nullptr); } } while (0)
        if (even) {
            EpiEvenIn E{(bf16_t*)(ws + WS_P), (bf16_t*)(ws + WS_P + SZ_HALF), (bf16_t*)(ws + WS_P + 2 * SZ_HALF), (bf16_t*)(ws + WS_P + 3 * SZ_HALF), (bf16_t*)(ws + WS_P + 4 * SZ_HALF), (const float*)(ws + WS_ROPE), rss1, bin + (size_t)i * 5 * 3072, lds};
            if (gridDim.x == 256 && M1 == MTOT) {
                run_gemm(lds, H, (const bf16_t*)(wb + WB_IN), NLAT, 3072, 1024, E); GSYNC();
                ph_ret_kv_conv_ho(P, lds, j, i, i == 0 ? 48 : 16, M2 == MTOT, E, (unsigned*)(ws + WS_CNT) + (i * 2 + 1) * 16); GSYNC();
                ph_scan(P, j); GSYNC();
                ph_ret_out(P, lds, j, M2 == MTOT, ho ? cnt2 : nullptr); if (ho) { g2c_tail(); convert_ffn_w(P, lds, i, (int)blockIdx.x - 48, 192); } else convert_ffn(P, lds, i, M2 == MTOT ? 544 : 512); GSYNC();
            } else {
                run_gemm(lds, H, (const bf16_t*)(wb + WB_IN), M1, 3072, 1024, E); convert_ffn(P, lds, i, (M1 / 256) * 12); GSYNC();
                ph_ret_kv_conv(P, lds, j, M2 / 32); GSYNC();
                ph_scan(P, j); GSYNC();
                ph_ret_out(P, lds, j, M2 == MTOT, nullptr); GSYNC();
            }
        } else {
            EpiOddIn E{(bf16_t*)(ws + WS_P), (bf16_t*)(ws + WS_P + SZ_HALF), rss1, bin + (size_t)i * 5 * 3072, lds};
            run_gemm(lds, H, (const bf16_t*)(wb + WB_IN), M1, 1536, 1024, E); convert_ffn(P, lds, i, (M1 / 256) * 6); GSYNC();
            ph_oddmix(P, lds, j, M2 / 128, ho ? cnt2 : nullptr); if (ho) g2c_tail(); GSYNC();
        }
        run_gemm(lds, MIX, (const bf16_t*)(wb + WB_OUT), ho ? NLAT : M2, 1024, 1024, Eout); GSYNC();
        const EpiRes Edn{XR, XR + (size_t)NLAT * D, XR, mod + (size_t)i * 5 * 6144 + 5 * 1024, i < 3 ? H : nullptr, wmt + (size_t)(i < 3 ? (i * 2 + 2) : 0) * 5 * 1024, rss1n, lds};
        const EpiGU Egu{ACT, rss2, bgu + (size_t)i * 5 * 5632, lds};
        const bool handoff = ho;
        if (handoff) {
            unsigned* cnt = (unsigned*)(ws + WS_CNT) + (i * 2 + 0) * 16;
            { pg8::Gemm g{H, (const bf16_t*)(wb + WB_GU), MTOT, 5632, 1024}; CtxFirstOrder S; S.nN = 22; S.c = (int)blockIdx.x; S.nctx = 88; S.ntot = 1496; S.spec = 56; S.cnt = cnt;
              pg8::gemm_phase<EpiGU, CtxFirstOrder, false>(lds, g, S, Egu, nullptr); }
            if (blockIdx.x >= 240) { wait_count(cnt, 8u * 88u);
                pg8::Gemm g{ACT, (const bf16_t*)(wb + WB_DN), MTOT, 1024, 2816}; OneUnitOrder S{64 + ((int)blockIdx.x - 240) / 4, ((int)blockIdx.x - 240) % 4};
                pg8::gemm_phase<EpiRes, OneUnitOrder, false>(lds, g, S, Edn, nullptr); }
            GSYNC();
            run_gemm(lds, ACT, (const bf16_t*)(wb + WB_DN), NLAT, 1024, 2816, Edn);
        } else {
            run_gemm(lds, H, (const bf16_t*)(wb + WB_GU), M2, 5632, 1024, Egu); GSYNC();
            run_gemm(lds, ACT, (const bf16_t*)(wb + WB_DN), M2, 1024, 2816, Edn);
        }
        if (i < 3) convert_inout(P, lds, i + 1);
        GSYNC();
    }
    ph_final(P);
}
}

extern "C" void kernel_launch(void* const* d_in, const int* in_sizes, int n_in, void* d_out, int out_size, void* d_ws, size_t ws_size, hipStream_t stream) {
    static int grid = 0;
    if (grid == 0) {
        if (n_in != 25 || ws_size < mk::WS_END) { fprintf(stderr, "kernel_launch: need 25 inputs and %zu bytes of workspace (got %d, %zu)\n", (size_t)mk::WS_END, n_in, ws_size); grid = -1; return; }
        int dev = 0, cus = 0, per_cu = 0;
        hipGetDevice(&dev); hipDeviceGetAttribute(&cus, hipDeviceAttributeMultiprocessorCount, dev);
        if (hipFuncSetAttribute((const void*)mk::mega, hipFuncAttributeMaxDynamicSharedMemorySize, mk::LDS_BYTES) != hipSuccess) { fprintf(stderr, "kernel_launch: hipFuncSetAttribute failed\n"); grid = -1; return; }
        if (hipOccupancyMaxActiveBlocksPerMultiprocessor(&per_cu, (const void*)mk::mega, 512, mk::LDS_BYTES) != hipSuccess || per_cu < 1) { fprintf(stderr, "kernel_launch: occupancy query failed (%d)\n", per_cu); grid = -1; return; }
        grid = cus * (per_cu > 1 ? 1 : per_cu);
    }
    if (grid < 0) return;
    mk::Params p{};
    const float** pp = (const float**)&p;
    for (int i = 0; i < 25; ++i) pp[i] = (const float*)d_in[i];
    p.out = (float*)d_out; p.ws = (unsigned char*)d_ws;
    void* args[] = {&p};
    hipError_t e = hipLaunchCooperativeKernel((const void*)mk::mega, dim3(grid), dim3(512), args, mk::LDS_BYTES, stream);
    if (e != hipSuccess) fprintf(stderr, "cooperative launch failed: %s (grid %d)\n", hipGetErrorString(e), grid);
}
```
